# Optimizing an MI355X kernel written in HIP

```python
import jax, jax.numpy as jnp
from jax import lax
import numpy as np

D_MODEL = 1024
BATCH = 2
SEQ = 16384
DEPTH = 1
DEC_BATCH = 16
DEC_SEQ = 4096
PAST_LEN = 128

GRID_W = 64
NA_HEADS = 8
NA_HEAD_DIM = 64
NA_WIDTH = NA_HEADS * NA_HEAD_DIM
NA_KH_MAX = 8
NA_KW = 16
NA_SLAB_W = 2 * NA_KW
MLA_HEADS = 8
MLA_NOPE_DIM = 64
MLA_ROPE_DIM = 32
MLA_QK_DIM = MLA_NOPE_DIM + MLA_ROPE_DIM
MLA_V_DIM = 64
MLA_Q_RANK = 384
MLA_KV_RANK = 256
MLA_WIDTH = MLA_HEADS * MLA_V_DIM
ROPE_BASE = 10000.0
Q_BLOCK = 128
D_FF = 2816
LN_EPS = 1e-5
RMS_EPS = 1e-6
IN_COLS = 3 * NA_WIDTH + MLA_Q_RANK + MLA_KV_RANK + MLA_ROPE_DIM + 2 * D_MODEL

kernel_name = "hybrid_na_mla_macaron_deepnorm_encoder"


def layer_norm(x, g, b):
    xf = x.astype(jnp.float32)
    mu = jnp.mean(xf, axis=-1, keepdims=True)
    var = jnp.mean(jnp.square(xf - mu), axis=-1, keepdims=True)
    return ((xf - mu) * lax.rsqrt(var + LN_EPS) * g + b).astype(x.dtype)


def rms_norm(x, g):
    xf = x.astype(jnp.float32)
    return (xf * lax.rsqrt(jnp.mean(jnp.square(xf), axis=-1, keepdims=True) + RMS_EPS) * g).astype(x.dtype)


def swiglu_ffn(x, w_in, w_out):
    a, u = jnp.split(x @ w_in, 2, axis=-1)
    return (jax.nn.silu(a) * u) @ w_out


def rope_tables(n):
    inv = 1.0 / (ROPE_BASE ** (jnp.arange(0, MLA_ROPE_DIM, 2, dtype=jnp.float32) / MLA_ROPE_DIM))
    ang = jnp.arange(n, dtype=jnp.float32)[:, None] * inv[None, :]
    return jnp.cos(ang), jnp.sin(ang)


def apply_rope(x, cos, sin):
    x1, x2 = jnp.split(x.astype(jnp.float32), 2, axis=-1)
    return jnp.concatenate([x1 * cos - x2 * sin, x1 * sin + x2 * cos], axis=-1).astype(x.dtype)


def neighbourhood_attention(q, k, v, rpb):
    b, n = q.shape[0], q.shape[1]
    rows = n // GRID_W
    kh = min(NA_KH_MAX, rows)
    ncb = GRID_W // NA_KW
    qg = q.reshape(b, rows, ncb, NA_KW, NA_HEADS, NA_HEAD_DIM)
    kg = k.reshape(b, rows, GRID_W, NA_HEADS, NA_HEAD_DIM)
    vg = v.reshape(b, rows, GRID_W, NA_HEADS, NA_HEAD_DIM)
    r = jnp.arange(rows)
    row_start = jnp.clip(r - kh // 2, 0, rows - kh)
    key_rows = row_start[:, None] + jnp.arange(kh)[None, :]
    j = jnp.arange(ncb)
    slab_start = jnp.clip(j * NA_KW - NA_KW // 2, 0, GRID_W - NA_SLAB_W)
    key_cols = slab_start[:, None] + jnp.arange(NA_SLAB_W)[None, :]
    ridx = key_rows[:, None, :, None]
    cidx = key_cols[None, :, None, :]
    k_slab = kg[:, ridx, cidx]
    v_slab = vg[:, ridx, cidx]
    q_cols = j[:, None] * NA_KW + jnp.arange(NA_KW)[None, :]
    win_start = jnp.clip(q_cols - NA_KW // 2, 0, GRID_W - NA_KW)
    kc = key_cols[:, None, :]
    in_win = (kc >= win_start[..., None]) & (kc < win_start[..., None] + NA_KW)
    dc = jnp.clip(kc - q_cols[:, :, None] + NA_KW - 1, 0, 2 * NA_KW - 2)
    dr = key_rows - r[:, None] + NA_KH_MAX - 1
    bias = rpb[:, dr[:, None, None, :, None], dc[None, :, :, None, :]]
    s = jnp.einsum('brjqhd,brjkwhd->bhrjqkw', qg, k_slab,
                   preferred_element_type=jnp.float32) * (NA_HEAD_DIM ** -0.5)
    s = s + bias[None].astype(jnp.float32)
    s = jnp.where(in_win[:, :, None, :], s, -jnp.inf)
    p = jax.nn.softmax(s, axis=(-2, -1))
    out = jnp.einsum('bhrjqkw,brjkwhd->brjqhd', p.astype(v.dtype), v_slab)
    return out.reshape(b, n, NA_WIDTH)


def latent_attention(c_q, c_kv, k_rope, q_norm_g, kv_norm_g, w_uq, w_ukv):
    b, n = c_q.shape[0], c_q.shape[1]
    q = (rms_norm(c_q, q_norm_g) @ w_uq).reshape(b, n, MLA_HEADS, MLA_QK_DIM)
    kv = (rms_norm(c_kv, kv_norm_g) @ w_ukv).reshape(b, n, MLA_HEADS, MLA_NOPE_DIM + MLA_V_DIM)
    q_nope, q_rope = q[..., :MLA_NOPE_DIM], q[..., MLA_NOPE_DIM:]
    k_nope, v = kv[..., :MLA_NOPE_DIM], kv[..., MLA_NOPE_DIM:]
    cos, sin = rope_tables(n)
    q_rope = apply_rope(q_rope, cos[:, None, :], sin[:, None, :])
    k_rope = apply_rope(k_rope, cos, sin)
    nb = n // Q_BLOCK
    qn_blocks = q_nope.reshape(b, nb, Q_BLOCK, MLA_HEADS, MLA_NOPE_DIM).transpose(1, 0, 2, 3, 4)
    qr_blocks = q_rope.reshape(b, nb, Q_BLOCK, MLA_HEADS, MLA_ROPE_DIM).transpose(1, 0, 2, 3, 4)
    scale = MLA_QK_DIM ** -0.5

    def attend(blk):
        qn, qr = blk
        s = (jnp.einsum('bqhd,bkhd->bhqk', qn, k_nope, preferred_element_type=jnp.float32)
             + jnp.einsum('bqhr,bkr->bhqk', qr, k_rope, preferred_element_type=jnp.float32)) * scale
        p = jax.nn.softmax(s, axis=-1)
        return jnp.einsum('bhqk,bkhd->bqhd', p.astype(v.dtype), v)

    out = lax.map(attend, (qn_blocks, qr_blocks))
    return out.transpose(1, 0, 2, 3, 4).reshape(b, n, MLA_WIDTH)


def token_mixer(x, w_in, b_gate, na_rpb, q_norm_g, kv_norm_g, w_uq, w_ukv, w_na_o, w_mla_o, w_out):
    offs = np.cumsum([NA_WIDTH, NA_WIDTH, NA_WIDTH, MLA_Q_RANK, MLA_KV_RANK, MLA_ROPE_DIM]).tolist()
    h = x @ w_in
    na_q, na_k, na_v, c_q, c_kv, k_rope, gate_logits = jnp.split(h, offs, axis=-1)
    b, n = x.shape[0], x.shape[1]
    hs = (b, n, NA_HEADS, NA_HEAD_DIM)
    y_a = neighbourhood_attention(na_q.reshape(hs), na_k.reshape(hs), na_v.reshape(hs), na_rpb) @ w_na_o
    y_b = latent_attention(c_q, c_kv, k_rope, q_norm_g, kv_norm_g, w_uq, w_ukv) @ w_mla_o
    g = jax.nn.sigmoid((gate_logits + b_gate).astype(jnp.float32)).astype(x.dtype)
    g_a, g_b = g[..., :D_MODEL], g[..., D_MODEL:]
    return (g_a * y_a + g_b * y_b) @ w_out


def encoder_layer(x, ffn1_w_in, ffn1_w_out, ln1_g, ln1_b, w_in, b_gate, na_rpb, q_norm_g, kv_norm_g,
                  w_uq, w_ukv, w_na_o, w_mla_o, w_out, ln2_g, ln2_b, ffn2_w_in, ffn2_w_out, ln3_g, ln3_b):
    alpha = (2.0 * DEPTH) ** 0.25
    x = layer_norm(alpha * x + 0.5 * swiglu_ffn(x, ffn1_w_in, ffn1_w_out), ln1_g, ln1_b)
    x = layer_norm(alpha * x + token_mixer(x, w_in, b_gate, na_rpb, q_norm_g, kv_norm_g, w_uq, w_ukv,
                                           w_na_o, w_mla_o, w_out), ln2_g, ln2_b)
    x = layer_norm(alpha * x + 0.5 * swiglu_ffn(x, ffn2_w_in, ffn2_w_out), ln3_g, ln3_b)
    return x


def run_trunk(x, ffn1_w_in, ffn1_w_out, ln1_g, ln1_b, w_in, b_gate, na_rpb, q_norm_g, kv_norm_g,
              w_uq, w_ukv, w_na_o, w_mla_o, w_out, ln2_g, ln2_b, ffn2_w_in, ffn2_w_out, ln3_g, ln3_b):
    for l in range(DEPTH):
        x = encoder_layer(x, ffn1_w_in[l], ffn1_w_out[l], ln1_g[l], ln1_b[l], w_in[l], b_gate[l], na_rpb[l],
                          q_norm_g[l], kv_norm_g[l], w_uq[l], w_ukv[l], w_na_o[l], w_mla_o[l], w_out[l],
                          ln2_g[l], ln2_b[l], ffn2_w_in[l], ffn2_w_out[l], ln3_g[l], ln3_b[l])
    return x


def setup_inputs(seed: int = 0) -> dict:
    key = jax.random.key(seed)
    ks = jax.random.split(key, 24)
    beta = (8.0 * DEPTH) ** -0.25
    f32 = jnp.float32

    def dense(k, shape, fan_in, scale=1.0):
        return jax.random.normal(k, shape, f32) * (fan_in ** -0.5) * scale

    def gain(k, shape):
        return 1.0 + 0.05 * jax.random.normal(k, shape, f32)

    def small(k, shape, s):
        return s * jax.random.normal(k, shape, f32)

    in_col_scale = jnp.concatenate([jnp.ones((2 * NA_WIDTH,), f32), jnp.full((NA_WIDTH,), beta, f32),
                                    jnp.ones((IN_COLS - 3 * NA_WIDTH,), f32)])
    ukv_col_scale = jnp.tile(jnp.concatenate([jnp.ones((MLA_NOPE_DIM,), f32),
                                              jnp.full((MLA_V_DIM,), beta, f32)]), MLA_HEADS)
    return {
        "x_prompt": jax.random.normal(ks[0], (BATCH, SEQ, D_MODEL), f32),
        "x_sample": jax.random.normal(ks[1], (DEC_BATCH, DEC_SEQ, D_MODEL), f32),
        "ffn1_w_in": dense(ks[2], (DEPTH, D_MODEL, 2 * D_FF), D_MODEL),
        "ffn1_w_out": dense(ks[3], (DEPTH, D_FF, D_MODEL), D_FF, beta),
        "ln1_g": gain(ks[4], (DEPTH, D_MODEL)),
        "ln1_b": small(ks[5], (DEPTH, D_MODEL), 0.02),
        "w_in": dense(ks[6], (DEPTH, D_MODEL, IN_COLS), D_MODEL) * in_col_scale,
        "b_gate": small(ks[7], (DEPTH, 2 * D_MODEL), 0.1),
        "na_rpb": small(ks[8], (DEPTH, NA_HEADS, 2 * NA_KH_MAX - 1, 2 * NA_KW - 1), 0.02),
        "q_norm_g": gain(ks[9], (DEPTH, MLA_Q_RANK)),
        "kv_norm_g": gain(ks[10], (DEPTH, MLA_KV_RANK)),
        "w_uq": dense(ks[11], (DEPTH, MLA_Q_RANK, MLA_HEADS * MLA_QK_DIM), MLA_Q_RANK),
        "w_ukv": dense(ks[12], (DEPTH, MLA_KV_RANK, MLA_HEADS * (MLA_NOPE_DIM + MLA_V_DIM)), MLA_KV_RANK) * ukv_col_scale,
        "w_na_o": dense(ks[13], (DEPTH, NA_WIDTH, D_MODEL), NA_WIDTH),
        "w_mla_o": dense(ks[14], (DEPTH, MLA_WIDTH, D_MODEL), MLA_WIDTH),
        "w_out": dense(ks[15], (DEPTH, D_MODEL, D_MODEL), D_MODEL, beta),
        "ln2_g": gain(ks[16], (DEPTH, D_MODEL)),
        "ln2_b": small(ks[17], (DEPTH, D_MODEL), 0.02),
        "ffn2_w_in": dense(ks[18], (DEPTH, D_MODEL, 2 * D_FF), D_MODEL),
        "ffn2_w_out": dense(ks[19], (DEPTH, D_FF, D_MODEL), D_FF, beta),
        "ln3_g": gain(ks[20], (DEPTH, D_MODEL)),
        "ln3_b": small(ks[21], (DEPTH, D_MODEL), 0.02),
    }


def reference(x_prompt, x_sample, ffn1_w_in, ffn1_w_out, ln1_g, ln1_b, w_in, b_gate, na_rpb, q_norm_g,
              kv_norm_g, w_uq, w_ukv, w_na_o, w_mla_o, w_out, ln2_g, ln2_b, ffn2_w_in, ffn2_w_out,
              ln3_g, ln3_b):
    y_prompt = run_trunk(x_prompt, ffn1_w_in, ffn1_w_out, ln1_g, ln1_b, w_in, b_gate, na_rpb, q_norm_g,
                         kv_norm_g, w_uq, w_ukv, w_na_o, w_mla_o, w_out, ln2_g, ln2_b, ffn2_w_in,
                         ffn2_w_out, ln3_g, ln3_b)
    y_sample = run_trunk(x_sample, ffn1_w_in, ffn1_w_out, ln1_g, ln1_b, w_in, b_gate, na_rpb, q_norm_g,
                         kv_norm_g, w_uq, w_ukv, w_na_o, w_mla_o, w_out, ln2_g, ln2_b, ffn2_w_in,
                         ffn2_w_out, ln3_g, ln3_b)
    return (y_prompt, y_sample)
```

```cpp
#include <hip/hip_runtime.h>
#include <hip/hip_cooperative_groups.h>
#include <cstdio>
#include <cstdint>
#include <cmath>
namespace cg = cooperative_groups;
namespace pg8 {
#define PG8_LAS __attribute__((address_space(3)))
typedef unsigned short bf16_t;
typedef short bf16x8 __attribute__((ext_vector_type(8)));
typedef float f32x4 __attribute__((ext_vector_type(4)));
typedef unsigned u32x4 __attribute__((ext_vector_type(4)));
constexpr int BM = 256, BK = 64, HALF = 128, HTB = HALF * BK * 2  , STAGE_BYTES = 8 * HTB, NXCD = 8, WGM = 8;

__host__ __device__ __forceinline__ int lds_byte(int r, int c) { const int st = (r >> 4) * 2 + (c >> 5), rr = r & 15, cc = c & 31, ob = rr * 64 + cc * 2; return st * 1024 + (ob ^ (((ob >> 9) & 1) << 5)); }
__host__ __device__ __forceinline__ void stage_rc(int b, int& R, int& C) { const int st = b / 1024, sb = b % 1024, swz = sb ^ (((sb >> 9) & 1) << 5); R = (st >> 1) * 16 + swz / 64; C = (st & 1) * 32 + (swz % 64) / 2; }
__host__ __device__ __forceinline__ int perm32(int rho) { const int n = rho >> 4, i = rho & 15; return 8 * (i >> 2) + 4 * n + (i & 3); }

struct Unit { int pm, pn; };
struct Gemm { const bf16_t* A; const bf16_t* Bt; int M, N, K, lda; };

struct StaticOrder {
    int nM, nN, nwg, G, c;
    __host__ __device__ void init(int M, int N, int G_, int c_) { nM = M / BM; nN = N / BM; nwg = nM * nN; G = G_; c = c_; }
    __host__ __device__ bool next(int i, Unit& u) const {
        const long L = (long)i * G + c; if (L >= nwg) return false;
        int wgid = (int)L; { const int q = nwg / NXCD, r = nwg % NXCD, xcd = wgid % NXCD, off = wgid / NXCD; wgid = (xcd < r ? xcd * (q + 1) : r * (q + 1) + (xcd - r) * q) + off; }
        const int nig = WGM * nN, gid = wgid / nig, fm = gid * WGM, gsz = (nM - fm) < WGM ? (nM - fm) : WGM;
        u.pm = fm + ((wgid % nig) % gsz); u.pn = (wgid % nig) / gsz; return true;
    }
    __device__ __forceinline__ void a_ready(const Unit&) const {}
    __device__ __forceinline__ void done(const Unit&) const {}
};


typedef unsigned u32x2 __attribute__((ext_vector_type(2)));
typedef float f32x2_t __attribute__((ext_vector_type(2))); typedef __bf16 bf16x2_t __attribute__((ext_vector_type(2)));
__device__ __forceinline__ unsigned cvt_pk_bf16(float lo, float hi) { f32x2_t v = {lo, hi}; bf16x2_t b = __builtin_convertvector(v, bf16x2_t); return __builtin_bit_cast(unsigned, b); }
__device__ __forceinline__ float bf_lo(unsigned w) { return __uint_as_float(w << 16); }
__device__ __forceinline__ float bf_hi(unsigned w) { return __uint_as_float(w & 0xffff0000u); }
__device__ __forceinline__ float fsigmoid(float x) { return __builtin_amdgcn_rcpf(1.0f + __builtin_amdgcn_exp2f(-1.4426950408889634f * x)); }

struct EpiSwiGLU {
    static constexpr bool PERM = true, AFTER_DRAIN = false;
    bf16_t* O; int ldc;
    __device__ __forceinline__ void operator()(const f32x4 (&acc)[2][2][4][2], const Unit& u, int wr, int wc, int fr, int fq) const {
        const int row0 = u.pm * BM + wr * 64 + fr, col0 = u.pn * HALF + wc * 32 + 8 * fq;
#pragma unroll
        for (int ai = 0; ai < 2; ++ai)
#pragma unroll
            for (int m = 0; m < 4; ++m) { bf16_t* rowp = O + (size_t)(row0 + ai * HALF + m * 16) * ldc + col0;
                f32x4 h0, h1;
#pragma unroll
                for (int e = 0; e < 4; ++e) { const float a0 = acc[ai][0][m][0][e], a1 = acc[ai][0][m][1][e];
                    h0[e] = a0 * fsigmoid(a0) * acc[ai][1][m][0][e]; h1[e] = a1 * fsigmoid(a1) * acc[ai][1][m][1][e]; }
                u32x4 w; w.x = cvt_pk_bf16(h0[0], h0[1]); w.y = cvt_pk_bf16(h0[2], h0[3]); w.z = cvt_pk_bf16(h1[0], h1[1]); w.w = cvt_pk_bf16(h1[2], h1[3]);
                *(u32x4*)rowp = w; }
    }
};
struct EpiResid {
    static constexpr bool PERM = false, AFTER_DRAIN = false;
    const float* base0; const float* base1; int split_pm; float* out; float alpha, s;
    __device__ __forceinline__ void operator()(const f32x4 (&acc)[2][2][4][2], const Unit& u, int wr, int wc, int fr, int fq) const {
        const int row0 = u.pm * BM + wr * 64 + fr, col0 = u.pn * BM + wc * 32 + 4 * fq;
        const float* base = (u.pm < split_pm) ? base0 : base1;
#pragma unroll
        for (int ai = 0; ai < 2; ++ai)
#pragma unroll
            for (int m = 0; m < 4; ++m) { const size_t off = (size_t)(row0 + ai * HALF + m * 16) * 1024 + col0;
#pragma unroll
                for (int bj = 0; bj < 2; ++bj)
#pragma unroll
                    for (int n = 0; n < 2; ++n) { const f32x4 b = *(const f32x4*)(base + off + bj * HALF + n * 16);
                        const f32x4 o = b * alpha + acc[ai][bj][m][n] * s; *(f32x4*)(out + off + bj * HALF + n * 16) = o; }
                asm volatile("" ::: "memory"); }
    }
};
template <int ACT> struct EpiBf16 {
    static constexpr bool PERM = true, AFTER_DRAIN = false;
    bf16_t* O0; int ld0; int nsplit; bf16_t* O1; int ld1; const float* bias;
    __device__ __forceinline__ void operator()(const f32x4 (&acc)[2][2][4][2], const Unit& u, int wr, int wc, int fr, int fq) const {
        bf16_t* base; int ld, colt;
        if (u.pn < nsplit) { base = O0; ld = ld0; colt = u.pn * BM; } else { base = O1; ld = ld1; colt = (u.pn - nsplit) * BM; }
        const int row0 = u.pm * BM + wr * 64 + fr, col0 = colt + wc * 32 + 8 * fq, bcol0 = u.pn * BM + wc * 32 + 8 * fq;
        f32x4 bv[2][2];
#pragma unroll
        for (int bj = 0; bj < 2; ++bj)
#pragma unroll
            for (int n = 0; n < 2; ++n) bv[bj][n] = ACT ? *(const f32x4*)(bias + bcol0 + bj * HALF + 4 * n) : (f32x4){0.f, 0.f, 0.f, 0.f};
#pragma unroll
        for (int ai = 0; ai < 2; ++ai)
#pragma unroll
            for (int m = 0; m < 4; ++m) { bf16_t* rowp = base + (size_t)(row0 + ai * HALF + m * 16) * ld + col0;
#pragma unroll
                for (int bj = 0; bj < 2; ++bj) { f32x4 v0 = acc[ai][bj][m][0], v1 = acc[ai][bj][m][1];
                    if (ACT) { v0 = v0 + bv[bj][0]; v1 = v1 + bv[bj][1];
#pragma unroll
                        for (int e = 0; e < 4; ++e) { v0[e] = fsigmoid(v0[e]); v1[e] = fsigmoid(v1[e]); } }
                    u32x4 w; w.x = cvt_pk_bf16(v0[0], v0[1]); w.y = cvt_pk_bf16(v0[2], v0[3]); w.z = cvt_pk_bf16(v1[0], v1[1]); w.w = cvt_pk_bf16(v1[2], v1[3]);
                    *(u32x4*)(rowp + bj * HALF) = w; } }
    }
};
template <int ACCUM> struct EpiGateMul {
    static constexpr bool PERM = true, AFTER_DRAIN = false;
    const bf16_t* G; int ldg; bf16_t* T; float sc;
    __device__ __forceinline__ void operator()(const f32x4 (&acc)[2][2][4][2], const Unit& u, int wr, int wc, int fr, int fq) const {
        const int row0 = u.pm * BM + wr * 64 + fr, col0 = u.pn * BM + wc * 32 + 8 * fq;
#pragma unroll
        for (int ai = 0; ai < 2; ++ai)
#pragma unroll
            for (int m = 0; m < 4; ++m) { const size_t row = (size_t)(row0 + ai * HALF + m * 16);
#pragma unroll
                for (int bj = 0; bj < 2; ++bj) { const u32x4 g = *(const u32x4*)(G + row * ldg + col0 + bj * HALF);
                    u32x4 t = (u32x4){0u, 0u, 0u, 0u}; if (ACCUM) t = *(const u32x4*)(T + row * 1024 + col0 + bj * HALF);
                    const f32x4 v0 = acc[ai][bj][m][0] * sc, v1 = acc[ai][bj][m][1] * sc;
                    u32x4 w;
                    w.x = cvt_pk_bf16(bf_lo(t.x) + bf_lo(g.x) * v0[0], bf_hi(t.x) + bf_hi(g.x) * v0[1]);
                    w.y = cvt_pk_bf16(bf_lo(t.y) + bf_lo(g.y) * v0[2], bf_hi(t.y) + bf_hi(g.y) * v0[3]);
                    w.z = cvt_pk_bf16(bf_lo(t.z) + bf_lo(g.z) * v1[0], bf_hi(t.z) + bf_hi(g.z) * v1[1]);
                    w.w = cvt_pk_bf16(bf_lo(t.w) + bf_lo(g.w) * v1[2], bf_hi(t.w) + bf_hi(g.w) * v1[3]);
                    *(u32x4*)(T + row * 1024 + col0 + bj * HALF) = w; asm volatile("" ::: "memory"); } }
    }
};
struct EpiQRope {
    static constexpr bool PERM = false, AFTER_DRAIN = false;
    bf16_t* Q; const float* cosT; const float* sinT; float qscale;
    __device__ __forceinline__ void operator()(const f32x4 (&acc)[2][2][4][2], const Unit& u, int wr, int wc, int fr, int fq) const {
        const int row0 = u.pm * BM + wr * 64 + fr;
        if (u.pn < 2) {
            const int col0 = u.pn * BM + wc * 32 + 4 * fq;
#pragma unroll
            for (int ai = 0; ai < 2; ++ai)
#pragma unroll
                for (int m = 0; m < 4; ++m) { bf16_t* rowp = Q + (size_t)(row0 + ai * HALF + m * 16) * 768 + col0;
#pragma unroll
                    for (int bj = 0; bj < 2; ++bj)
#pragma unroll
                        for (int n = 0; n < 2; ++n) { const f32x4 v = acc[ai][bj][m][n] * qscale; u32x2 w; w.x = cvt_pk_bf16(v[0], v[1]); w.y = cvt_pk_bf16(v[2], v[3]);
                            *(u32x2*)(rowp + bj * HALF + n * 16) = w; } }
        } else {
#pragma unroll
            for (int ai = 0; ai < 2; ++ai)
#pragma unroll
                for (int m = 0; m < 4; ++m) { const int row = row0 + ai * HALF + m * 16; const int pos = row < 32768 ? (row & 16383) : (row & 4095);
                    const f32x4 cs = *(const f32x4*)(cosT + pos * 16 + 4 * fq), sn = *(const f32x4*)(sinT + pos * 16 + 4 * fq);
                    bf16_t* rowp = Q + (size_t)row * 768 + 512 + 4 * fq;
#pragma unroll
                    for (int bj = 0; bj < 2; ++bj) { const f32x4 x1 = acc[ai][bj][m][0], x2 = acc[ai][bj][m][1];
                        const f32x4 o1 = (x1 * cs - x2 * sn) * qscale, o2 = (x1 * sn + x2 * cs) * qscale; const int head = 4 * bj + wc;
                        u32x2 w1, w2; w1.x = cvt_pk_bf16(o1[0], o1[1]); w1.y = cvt_pk_bf16(o1[2], o1[3]); w2.x = cvt_pk_bf16(o2[0], o2[1]); w2.y = cvt_pk_bf16(o2[2], o2[3]);
                        *(u32x2*)(rowp + head * 32) = w1; *(u32x2*)(rowp + head * 32 + 16) = w2; }
                    asm volatile("" ::: "memory"); }
        }
    }
};

template <class Epi, class Sched, bool ALIGN_EPI = false, bool SP2 = false>
__device__ __forceinline__ void gemm_phase(PG8_LAS unsigned char* lds, const Gemm g, const Sched& S, const Epi& E) {
    int tid_raw = threadIdx.x; asm volatile("" : "+v"(tid_raw));
    const int tid = tid_raw, wid = __builtin_amdgcn_readfirstlane(tid >> 6), lane = tid & 63, wr = wid >> 2, wc = wid & 3, fr = lane & 15, fq = lane >> 4;
    int K_raw = g.K; asm volatile("" : "+s"(K_raw));
    const int K = K_raw, nt = K / BK;
    unsigned voffA[2], voffB[2];
#pragma unroll
    for (int i = 0; i < 2; ++i) { int R, C; stage_rc(tid * 16 + i * 8192, R, C); const int Rb = Epi::PERM ? ((R & ~31) + perm32(R & 31)) : R;
        voffA[i] = (unsigned)(R * g.lda + C) * 2u; voffB[i] = (unsigned)(Rb * K + C) * 2u; }
    const size_t kstep = (size_t)(BK * 2);
    const size_t hstepB = (size_t)HALF * K * 2, hstepA = (size_t)HALF * g.lda * 2;
    const size_t tstepA = 2 * hstepA, tstepB = 2 * hstepB;
    const unsigned ldsw = (unsigned)wid * 1024u;
    const int aoff = lds_byte(wr * 64 + fr, fq * 8), boff = lds_byte(wc * 32 + fr, fq * 8);
#define PG8_SA(b, h) (((b) * 2 + (h)) * HTB)
#define PG8_SB(b, h) ((4 + (b) * 2 + (h)) * HTB)
#define PG8_STAGE(bufoff, gbase, voff) do { _Pragma("unroll") for (int _i = 0; _i < 2; ++_i) \
        __builtin_amdgcn_global_load_lds((const unsigned*)((const char*)(gbase) + (voff)[_i]), (PG8_LAS unsigned*)(lds + (bufoff) + ldsw + _i * 8192), 16, 0, 0); } while (0)
#define PG8_LDA(dst, b, h) do { _Pragma("unroll") for (int m = 0; m < 4; ++m) _Pragma("unroll") for (int k = 0; k < 2; ++k) dst[m][k] = *(const PG8_LAS bf16x8*)(lds + PG8_SA(b, h) + aoff + m * 2048 + k * 1024); } while (0)
#define PG8_LDB(dst, b, h) do { _Pragma("unroll") for (int n = 0; n < 2; ++n) _Pragma("unroll") for (int k = 0; k < 2; ++k) dst[n][k] = *(const PG8_LAS bf16x8*)(lds + PG8_SB(b, h) + boff + n * 2048 + k * 1024); } while (0)
#define PG8_MMA(ai, bj, At, Bt) do { __builtin_amdgcn_s_setprio(1); _Pragma("unroll") for (int m = 0; m < 4; ++m) _Pragma("unroll") for (int n = 0; n < 2; ++n) _Pragma("unroll") for (int k = 0; k < 2; ++k) \
        acc[ai][bj][m][n] = __builtin_amdgcn_mfma_f32_16x16x32_bf16(Bt[n][k], At[m][k], acc[ai][bj][m][n], 0, 0, 0); __builtin_amdgcn_s_setprio(0); } while (0)
#define PG8_WAIT_V(n) asm volatile("s_waitcnt vmcnt(" #n ")" ::: "memory")
#define PG8_WAIT_L(n) asm volatile("s_waitcnt lgkmcnt(" #n ")" ::: "memory")
#define PG8_BAR __builtin_amdgcn_s_barrier()
#define PG8_SCHED __builtin_amdgcn_sched_barrier(0)
    Unit cur, nxt; int ui = 0;
    if (!S.next(0, cur)) return;
    f32x4 acc[2][2][4][2];
#pragma unroll
    for (int a = 0; a < 2; ++a)
#pragma unroll
        for (int b = 0; b < 2; ++b)
#pragma unroll
            for (int m = 0; m < 4; ++m)
#pragma unroll
                for (int n = 0; n < 2; ++n) acc[a][b][m][n] = (f32x4){0.f, 0.f, 0.f, 0.f};
    bf16x8 At[4][2], B0[2][2], B1[2][2];
    const char* cA = (const char*)g.A + (size_t)cur.pm * tstepA; const char* cB = (const char*)g.Bt + (size_t)cur.pn * tstepB;
    S.a_ready(cur);
    if constexpr (SP2) {
        PG8_STAGE(PG8_SB(0, 0), cB, voffB); PG8_STAGE(PG8_SB(0, 1), cB + hstepB, voffB); PG8_STAGE(PG8_SA(0, 0), cA, voffA); PG8_STAGE(PG8_SA(0, 1), cA + hstepA, voffA);
        if (wr == 1) PG8_BAR;
        PG8_WAIT_V(2); PG8_BAR;
        PG8_STAGE(PG8_SB(1, 0), cB + kstep, voffB); PG8_STAGE(PG8_SA(1, 0), cA + kstep, voffA); PG8_STAGE(PG8_SB(1, 1), cB + hstepB + kstep, voffB);
        PG8_WAIT_V(6); PG8_BAR;
    } else {
        PG8_STAGE(PG8_SB(0, 0), cB, voffB); PG8_STAGE(PG8_SA(0, 0), cA, voffA); PG8_STAGE(PG8_SB(0, 1), cB + hstepB, voffB); PG8_STAGE(PG8_SA(0, 1), cA + hstepA, voffA);
        if (wr == 1) PG8_BAR;
        PG8_WAIT_V(4); PG8_BAR;
        PG8_STAGE(PG8_SB(1, 0), cB + kstep, voffB); PG8_STAGE(PG8_SA(1, 0), cA + kstep, voffA); PG8_STAGE(PG8_SB(1, 1), cB + hstepB + kstep, voffB);
        PG8_WAIT_V(6); PG8_BAR;
    }
    for (;;) {
        const bool has_next = S.next(ui + 1, nxt);
        const char* nA = has_next ? (const char*)g.A + (size_t)nxt.pm * tstepA : cA; const char* nB = has_next ? (const char*)g.Bt + (size_t)nxt.pn * tstepB : cB;
        for (int t = 0; t < nt; t += 2) {
            const bool last = (t == nt - 2);
            const char* a1 = cA + (size_t)(t + 1) * kstep;
            const char* a2 = last ? nA : cA + (size_t)(t + 2) * kstep; const char* b2 = last ? nB : cB + (size_t)(t + 2) * kstep;
            const char* a3 = a2 + kstep; const char* b3 = b2 + kstep;
            if (last && has_next) S.a_ready(nxt);
            if constexpr (SP2) {
            PG8_LDB(B0, 0, 0); PG8_LDB(B1, 0, 1); PG8_SCHED; PG8_LDA(At, 0, 0); PG8_STAGE(PG8_SA(1, 1), a1 + hstepA, voffA);
            PG8_WAIT_V(8); PG8_WAIT_L(0); PG8_BAR; PG8_MMA(0, 0, At, B0); PG8_MMA(0, 1, At, B1); PG8_BAR; PG8_SCHED;
            PG8_LDA(At, 0, 1); PG8_STAGE(PG8_SB(0, 0), b2, voffB); PG8_STAGE(PG8_SB(0, 1), b2 + hstepB, voffB); PG8_STAGE(PG8_SA(0, 0), a2, voffA);
            PG8_WAIT_V(8); PG8_WAIT_L(0); PG8_BAR; PG8_MMA(1, 0, At, B0); PG8_MMA(1, 1, At, B1); PG8_BAR; PG8_SCHED;
            PG8_LDB(B0, 1, 0); PG8_LDB(B1, 1, 1); PG8_SCHED; PG8_LDA(At, 1, 0); PG8_STAGE(PG8_SA(0, 1), a2 + hstepA, voffA);
            PG8_WAIT_V(8); PG8_WAIT_L(0); PG8_BAR; PG8_MMA(0, 0, At, B0); PG8_MMA(0, 1, At, B1); PG8_BAR; PG8_SCHED;
            PG8_LDA(At, 1, 1); PG8_STAGE(PG8_SB(1, 0), b3, voffB); PG8_STAGE(PG8_SB(1, 1), b3 + hstepB, voffB); PG8_STAGE(PG8_SA(1, 0), a3, voffA);
            PG8_WAIT_V(8); PG8_WAIT_L(0); PG8_BAR; PG8_MMA(1, 0, At, B0); PG8_MMA(1, 1, At, B1); PG8_BAR; PG8_SCHED;
            } else {
            PG8_LDB(B0, 0, 0); PG8_SCHED; PG8_LDA(At, 0, 0); PG8_STAGE(PG8_SA(1, 1), a1 + hstepA, voffA);
            PG8_WAIT_L(8); PG8_BAR; PG8_WAIT_L(0); PG8_MMA(0, 0, At, B0); PG8_BAR; PG8_SCHED;
            PG8_LDB(B1, 0, 1); PG8_STAGE(PG8_SB(0, 0), b2, voffB);
            PG8_BAR; PG8_WAIT_L(0); PG8_MMA(0, 1, At, B1); PG8_BAR;
            PG8_LDA(At, 0, 1); PG8_STAGE(PG8_SA(0, 0), a2, voffA);
            PG8_BAR; PG8_WAIT_L(0); PG8_MMA(1, 0, At, B0); PG8_BAR; PG8_SCHED;
            PG8_STAGE(PG8_SB(0, 1), b2 + hstepB, voffB);
            PG8_WAIT_V(6); PG8_BAR; PG8_MMA(1, 1, At, B1); PG8_BAR;
            PG8_LDB(B0, 1, 0); PG8_SCHED; PG8_LDA(At, 1, 0); PG8_STAGE(PG8_SA(0, 1), a2 + hstepA, voffA);
            PG8_WAIT_L(8); PG8_BAR; PG8_WAIT_L(0); PG8_MMA(0, 0, At, B0); PG8_BAR; PG8_SCHED;
            PG8_LDB(B1, 1, 1); PG8_STAGE(PG8_SB(1, 0), b3, voffB);
            PG8_BAR; PG8_WAIT_L(0); PG8_MMA(0, 1, At, B1); PG8_BAR;
            PG8_LDA(At, 1, 1); PG8_STAGE(PG8_SA(1, 0), a3, voffA);
            PG8_BAR; PG8_WAIT_L(0); PG8_MMA(1, 0, At, B0); PG8_BAR; PG8_SCHED;
            PG8_STAGE(PG8_SB(1, 1), b3 + hstepB, voffB);
            PG8_WAIT_V(6); PG8_BAR; PG8_MMA(1, 1, At, B1); PG8_BAR;
            }
        }
        if constexpr (ALIGN_EPI) { if (wr == 0) PG8_BAR; }
        if constexpr (!Epi::AFTER_DRAIN) { E(acc, cur, wr, wc, fr, fq); S.done(cur); }
        if (!has_next) break;
#pragma unroll
        for (int a = 0; a < 2; ++a)
#pragma unroll
            for (int b = 0; b < 2; ++b)
#pragma unroll
                for (int m = 0; m < 4; ++m)
#pragma unroll
                    for (int n = 0; n < 2; ++n) acc[a][b][m][n] = (f32x4){0.f, 0.f, 0.f, 0.f};
        cur = nxt; cA = nA; cB = nB; ++ui;
        if constexpr (ALIGN_EPI) { if (wr == 1) PG8_BAR; }
    }
    PG8_WAIT_V(0);
    if constexpr (!ALIGN_EPI) { if (wr == 0) PG8_BAR; }
    PG8_BAR;
    if constexpr (Epi::AFTER_DRAIN) { E.fused(acc, cur, wr, wc, fr, fq, lds, wid, lane); S.done(cur); }
#undef PG8_SA
#undef PG8_SB
#undef PG8_STAGE
#undef PG8_LDA
#undef PG8_LDB
#undef PG8_MMA
#undef PG8_WAIT_V
#undef PG8_WAIT_L
#undef PG8_BAR
#undef PG8_SCHED
}
}

constexpr int DM = 1024, DFF = 2816, MTOK = 98304, MPROMPT = 32768, SEQ_P = 16384, SEQ_S = 4096;
constexpr int NWAVES = 8;
constexpr float LN_EPS = 1e-5f, RMS_EPS = 1e-6f;
constexpr float ALPHA = 1.189207115002721f;
constexpr float QSCALE = 0.10206207261596575f * 1.4426950408889634f;

#define GAS __attribute__((address_space(1)))
#define LAS __attribute__((address_space(3)))
typedef unsigned short bf16;
typedef unsigned v4u __attribute__((ext_vector_type(4)));
typedef unsigned v2u __attribute__((ext_vector_type(2)));
typedef float f32x4 __attribute__((ext_vector_type(4)));
typedef float f32x16 __attribute__((ext_vector_type(16)));
typedef short bf16x8 __attribute__((ext_vector_type(8)));
typedef short s16x4 __attribute__((ext_vector_type(4)));
typedef short v4i16_t __attribute__((ext_vector_type(4)));

constexpr size_t MiB = 1u << 20;
constexpr size_t WS_W1IN = 0, WS_W1OUT = 12 * MiB, WS_W2IN = 18 * MiB, WS_W2OUT = 30 * MiB, WS_WIN = 36 * MiB, WS_WG = 41 * MiB, WS_WUQ = 45 * MiB, WS_WUKV = 46 * MiB,
                 WS_WNAO = 47 * MiB, WS_WMLAO = 48 * MiB, WS_WOUT = 49 * MiB, WS_ROPE = 52 * MiB  , WS_XB = 54 * MiB, WS_R = 246 * MiB, WS_END = 1023 * MiB;
constexpr size_t R_ACT = 0, R_NAQKV = 0  , R_C = 288 * MiB  , R_Q = 432 * MiB  , R_MLAO = 585 * MiB  , R_NAO = 681 * MiB  ,
                 R_KV = 0  , R_KR = 576 * MiB  , R_G = 0  , R_T = 384 * MiB  ;
static_assert((size_t)DM * 2 * DFF * 2 <= 12 * MiB && (size_t)DFF * DM * 2 <= 6 * MiB && 2304 * 1024 * 2 <= 5 * MiB, "weights map");
static_assert(WS_R + 777 * MiB <= WS_END && WS_XB + (size_t)MTOK * DM * 2 <= WS_R, "ws map");

constexpr int RING_BYTES = 131072, LDS_BYTES = 147456;

__device__ __forceinline__ unsigned f2bf(float f) { unsigned u = __builtin_bit_cast(unsigned, f); return (u + 0x7fffu + ((u >> 16) & 1u)) >> 16; }
__device__ __forceinline__ unsigned pk2(float lo, float hi) { return f2bf(lo) | (f2bf(hi) << 16); }
__device__ __forceinline__ float bflo(unsigned w) { return __uint_as_float(w << 16); }
__device__ __forceinline__ float bfhi(unsigned w) { return __uint_as_float(w & 0xffff0000u); }
__device__ __forceinline__ float wave_sum(float v) {
#pragma unroll
    for (int o = 1; o < 64; o <<= 1) v += __shfl_xor(v, o);
    return v;
}

__device__ __forceinline__ void p0_transpose_item(const float* W, int K, int N, bf16* WT, int dst_row0, LAS float* scr, int kb, int nb, int lane) {
    const int k0 = 64 * kb, n0 = 32 * nb;
#pragma unroll 8
    for (int i = 0; i < 32; ++i) { const int kk = 2 * i + (lane >> 5); scr[kk * 33 + (lane & 31)] = W[(size_t)(k0 + kk) * N + n0 + (lane & 31)]; }
    asm volatile("s_waitcnt lgkmcnt(0)" ::: "memory");
    const int c = lane & 7;
#pragma unroll
    for (int j = 0; j < 4; ++j) { const int n = (lane >> 3) + 8 * j; const LAS float* s = scr + (8 * c) * 33 + n;
        v4u o; o.x = pk2(s[0 * 33], s[1 * 33]); o.y = pk2(s[2 * 33], s[3 * 33]); o.z = pk2(s[4 * 33], s[5 * 33]); o.w = pk2(s[6 * 33], s[7 * 33]);
        *(v4u*)(WT + (size_t)(dst_row0 + n) * K + k0 + 8 * c) = o; }
    asm volatile("s_waitcnt lgkmcnt(0)" ::: "memory");
}

template <bool LN, bool WF32, bool WBF>
__device__ __forceinline__ void rows_phase(const float* X, float* XO, bf16* XB, const float* gam, const float* bet, int row_lo, int row_hi, int gw, int NGW, int lane) {
    f32x4 g[4], b[4];
    if (LN) {
#pragma unroll
        for (int j = 0; j < 4; ++j) { g[j] = ((const f32x4*)gam)[lane + 64 * j]; b[j] = ((const f32x4*)bet)[lane + 64 * j]; }
    }
    for (int m = row_lo + gw; m < row_hi; m += NGW) {
        const f32x4* xr = (const f32x4*)(X + (size_t)(m - row_lo) * DM) + lane;
        f32x4 v[4]; float s = 0.f;
#pragma unroll
        for (int j = 0; j < 4; ++j) { v[j] = xr[64 * j]; s += (v[j].x + v[j].y) + (v[j].z + v[j].w); }
        if (LN) {
            const float mean = wave_sum(s) * (1.f / DM); float s2 = 0.f;
#pragma unroll
            for (int j = 0; j < 4; ++j) { v[j] = v[j] - mean; s2 += (v[j].x * v[j].x + v[j].y * v[j].y) + (v[j].z * v[j].z + v[j].w * v[j].w); }
            const float rstd = 1.f / sqrtf(wave_sum(s2) * (1.f / DM) + LN_EPS);
#pragma unroll
            for (int j = 0; j < 4; ++j) v[j] = v[j] * rstd * g[j] + b[j];
        }
        if (WF32) { f32x4* xo = (f32x4*)(XO + (size_t)m * DM) + lane;
#pragma unroll
            for (int j = 0; j < 4; ++j) xo[64 * j] = v[j]; }
        if (WBF) { v2u* o8 = (v2u*)(XB + (size_t)m * DM) + lane;
#pragma unroll
            for (int j = 0; j < 4; ++j) { v2u w; w.x = pk2(v[j].x, v[j].y); w.y = pk2(v[j].z, v[j].w); o8[64 * j] = w; } }
    }
}

__device__ __forceinline__ void prep_phase(bf16* C, bf16* KR, const float* qg, const float* kvg, const float* cosT, const float* sinT, int gw, int NGW, int lane) {
    f32x4 gkv = ((const f32x4*)kvg)[lane];
    float gq[6];
#pragma unroll
    for (int k = 0; k < 3; ++k) { gq[2 * k] = qg[2 * (lane + 64 * k)]; gq[2 * k + 1] = qg[2 * (lane + 64 * k) + 1]; }
    for (int m = gw; m < MTOK; m += NGW) {
        bf16* row = C + (size_t)m * 768;
        const v2u kv = *(const v2u*)(row + 4 * lane);
        unsigned qw[3];
#pragma unroll
        for (int k = 0; k < 3; ++k) qw[k] = *(const unsigned*)(row + 256 + 2 * (lane + 64 * k));
        float x1 = 0.f, x2 = 0.f;
        if (lane < 16) { x1 = __uint_as_float((unsigned)row[640 + lane] << 16); x2 = __uint_as_float((unsigned)row[656 + lane] << 16); }
        const float a0 = bflo(kv.x), a1 = bfhi(kv.x), a2 = bflo(kv.y), a3 = bfhi(kv.y);
        const float skv = wave_sum((a0 * a0 + a1 * a1) + (a2 * a2 + a3 * a3));
        float q[6]; float sq = 0.f;
#pragma unroll
        for (int k = 0; k < 3; ++k) { q[2 * k] = bflo(qw[k]); q[2 * k + 1] = bfhi(qw[k]); sq += q[2 * k] * q[2 * k] + q[2 * k + 1] * q[2 * k + 1]; }
        sq = wave_sum(sq);
        const float rkv = 1.f / sqrtf(skv * (1.f / 256.f) + RMS_EPS), rq = 1.f / sqrtf(sq * (1.f / 384.f) + RMS_EPS);
        v2u okv; okv.x = pk2(a0 * rkv * gkv.x, a1 * rkv * gkv.y); okv.y = pk2(a2 * rkv * gkv.z, a3 * rkv * gkv.w);
        *(v2u*)(row + 4 * lane) = okv;
#pragma unroll
        for (int k = 0; k < 3; ++k) *(unsigned*)(row + 256 + 2 * (lane + 64 * k)) = pk2(q[2 * k] * rq * gq[2 * k], q[2 * k + 1] * rq * gq[2 * k + 1]);
        if (lane < 16) { const int pos = m < MPROMPT ? (m & (SEQ_P - 1)) : (m & (SEQ_S - 1)); const float c = cosT[pos * 16 + lane], s = sinT[pos * 16 + lane];
            KR[(size_t)m * 32 + lane] = (bf16)f2bf(x1 * c - x2 * s); KR[(size_t)m * 32 + 16 + lane] = (bf16)f2bf(x1 * s + x2 * c); }
    }
}

__device__ __forceinline__ void na_task(LAS unsigned char* ldsw, const bf16* QKV, bf16* O, const float* rpb, int seq0, int rows, int r, int j, int h, int lane) {
    const int q = lane & 15, g = lane >> 4;
    int row_start = r - 4; row_start = row_start < 0 ? 0 : (row_start > rows - 8 ? rows - 8 : row_start);
    int slab_start = 16 * j - 8; slab_start = slab_start < 0 ? 0 : (slab_start > 32 ? 32 : slab_start);
    const int qcol = 16 * j + q; int win_start = qcol - 8; win_start = win_start < 0 ? 0 : (win_start > 48 ? 48 : win_start);
    const bf16* qp = QKV + (size_t)(seq0 + r * 64 + qcol) * 1536 + h * 64 + g * 8;
    const bf16x8 qf0 = *(const bf16x8*)qp, qf1 = *(const bf16x8*)(qp + 32);
    f32x4 st[16];
#pragma unroll
    for (int kt = 0; kt < 16; ++kt) {
        const bf16* kp = QKV + (size_t)(seq0 + (row_start + (kt >> 1)) * 64 + slab_start + 16 * (kt & 1) + q) * 1536 + 512 + h * 64 + g * 8;
        const bf16x8 k0 = *(const bf16x8*)kp, k1 = *(const bf16x8*)(kp + 32);
        f32x4 a = (f32x4){0.f, 0.f, 0.f, 0.f};
        a = __builtin_amdgcn_mfma_f32_16x16x32_bf16(k0, qf0, a, 0, 0, 0);
        a = __builtin_amdgcn_mfma_f32_16x16x32_bf16(k1, qf1, a, 0, 0, 0);
        st[kt] = a;
    }
    const float* rp = rpb + h * (15 * 31);
    float mx = -INFINITY;
#pragma unroll
    for (int kt = 0; kt < 16; ++kt) {
        const int dr = row_start + (kt >> 1) - r + 7;
#pragma unroll
        for (int e = 0; e < 4; ++e) {
            const int scol = slab_start + 16 * (kt & 1) + 4 * g + e; int dc = scol - qcol + 15; dc = dc < 0 ? 0 : (dc > 30 ? 30 : dc);
            const bool valid = (scol >= win_start) && (scol < win_start + 16);
            float s = (st[kt][e] * 0.125f + rp[dr * 31 + dc]) * 1.4426950408889634f;
            s = valid ? s : -INFINITY; st[kt][e] = s; mx = fmaxf(mx, s);
        }
    }
    mx = fmaxf(mx, __shfl_xor(mx, 16)); mx = fmaxf(mx, __shfl_xor(mx, 32));
    float sum = 0.f;
#pragma unroll
    for (int kt = 0; kt < 16; ++kt)
#pragma unroll
        for (int e = 0; e < 4; ++e) { const float p = __builtin_amdgcn_exp2f(st[kt][e] - mx); st[kt][e] = p; sum += p; }
    sum += __shfl_xor(sum, 16); sum += __shfl_xor(sum, 32);
    const float inv = 1.0f / sum;
    f32x4 o[4];
#pragma unroll
    for (int c = 0; c < 4; ++c) o[c] = (f32x4){0.f, 0.f, 0.f, 0.f};
    const int q4 = (lane & 15) >> 2, p = lane & 3;
#pragma unroll
    for (int kr = 0; kr < 8; ++kr) {
        v4u vreg[4];
#pragma unroll
        for (int ii = 0; ii < 4; ++ii) { const int rw = 8 * ii + (lane >> 3), ch = lane & 7;
            vreg[ii] = *(const v4u*)(QKV + (size_t)(seq0 + (row_start + kr) * 64 + slab_start + rw) * 1536 + 1024 + h * 64 + ch * 8); }
#pragma unroll
        for (int ii = 0; ii < 4; ++ii) { const int rw = 8 * ii + (lane >> 3), ch = lane & 7; *(LAS v4u*)(ldsw + rw * 144 + ch * 16) = vreg[ii]; }
        asm volatile("s_waitcnt lgkmcnt(0)" ::: "memory");
        v4u pa; pa.x = pg8::cvt_pk_bf16(st[2 * kr][0], st[2 * kr][1]); pa.y = pg8::cvt_pk_bf16(st[2 * kr][2], st[2 * kr][3]);
        pa.z = pg8::cvt_pk_bf16(st[2 * kr + 1][0], st[2 * kr + 1][1]); pa.w = pg8::cvt_pk_bf16(st[2 * kr + 1][2], st[2 * kr + 1][3]);
#pragma unroll
        for (int c = 0; c < 4; ++c) {
            const s16x4 lo = __builtin_bit_cast(s16x4, __builtin_amdgcn_ds_read_tr16_b64_v4i16((LAS v4i16_t*)(ldsw + (4 * g + q4) * 144 + (16 * c + 4 * p) * 2)));
            const s16x4 hi = __builtin_bit_cast(s16x4, __builtin_amdgcn_ds_read_tr16_b64_v4i16((LAS v4i16_t*)(ldsw + (16 + 4 * g + q4) * 144 + (16 * c + 4 * p) * 2)));
            const bf16x8 vb = (bf16x8){lo[0], lo[1], lo[2], lo[3], hi[0], hi[1], hi[2], hi[3]};
            o[c] = __builtin_amdgcn_mfma_f32_16x16x32_bf16(__builtin_bit_cast(bf16x8, pa), vb, o[c], 0, 0, 0);
        }
        asm volatile("s_waitcnt lgkmcnt(0)" ::: "memory");
    }
#pragma unroll
    for (int e = 0; e < 4; ++e) { const float li = __shfl(inv, 4 * g + e);
        bf16* op = O + (size_t)(seq0 + r * 64 + 16 * j + 4 * g + e) * 512 + h * 64 + (lane & 15);
#pragma unroll
        for (int c = 0; c < 4; ++c) op[16 * c] = (bf16)f2bf(o[c][e] * li); }
}

namespace mla {
constexpr int SLOT = 20480;
constexpr int WSF = 2 * SLOT;
__device__ __forceinline__ int crow(int r, int hi) { return (r & 3) + 8 * (r >> 2) + 4 * hi; }
__device__ __forceinline__ unsigned cvtpk(float lo, float hi) { return pg8::cvt_pk_bf16(lo, hi); }
template <int THR>
__device__ __forceinline__ void unit(LAS unsigned char* lds, const bf16* Q, const bf16* KV, const bf16* KR, bf16* O, int tok0, int nkt, int h, int qb) {
    int tid_raw = threadIdx.x; asm volatile("" : "+v"(tid_raw));
    const int tid = tid_raw, lane = tid & 63, r32 = lane & 31, hi = lane >> 5; const int wid = __builtin_amdgcn_readfirstlane(tid >> 6);
    LAS float* wsf = (LAS float*)(lds + WSF) + wid * 64;
    const int krow = tid >> 3, kch = tid & 7;
    const bf16* kg = KV + (size_t)(tok0 + krow) * 1024 + h * 64 + kch * 8;
    const bf16* vg = kg + 512;
    const int rrow = (tid & 255) >> 2, rch = tid & 3;
    const bf16* rg = KR + (size_t)(tok0 + rrow) * 32 + rch * 8;
    const int kdst = kch * 1024 + krow * 16, rdst = 8192 + rch * 1024 + rrow * 16, vdst = 12288 + (kch >> 2) * 4096 + krow * 64 + (kch & 3) * 16;
    const bool do_r = wid < 4;
    const bf16* Qw = Q + (size_t)(tok0 + qb * 256 + wid * 32 + r32) * 768;
    bf16x8 qr[6];
#pragma unroll
    for (int d0 = 0; d0 < 4; ++d0) qr[d0] = *(const bf16x8*)(Qw + h * 64 + d0 * 16 + hi * 8);
    qr[4] = *(const bf16x8*)(Qw + 512 + h * 32 + hi * 8); qr[5] = *(const bf16x8*)(Qw + 512 + h * 32 + 16 + hi * 8);
    const int koff = hi * 1024 + r32 * 16;
    const int voff = 12288 + ((lane >> 4) & 1) * 32 + (lane & 3) * 8 + (4 * hi + ((lane & 15) >> 2)) * 64;
    f32x16 o0, o1, negm;
#pragma unroll
    for (int r = 0; r < 16; ++r) { o0[r] = 0.f; o1[r] = 0.f; negm[r] = 0.f; }
    float mhat = 0.f, l = 0.f;
    v4u kreg, vreg, rreg = (v4u){0u, 0u, 0u, 0u};
    kreg = *(const v4u*)kg; vreg = *(const v4u*)vg; if (do_r) rreg = *(const v4u*)rg;
    *(LAS v4u*)(lds + kdst) = kreg; *(LAS v4u*)(lds + vdst) = vreg; if (do_r) *(LAS v4u*)(lds + rdst) = rreg;
    __syncthreads();
    for (int t = 0; t < nkt; ++t) {
        const int cur = (t & 1) * SLOT, nxt = SLOT - cur;
        const bool more = (t + 1 < nkt);
        if (more) { kreg = *(const v4u*)(kg + (size_t)(t + 1) * 65536); vreg = *(const v4u*)(vg + (size_t)(t + 1) * 65536); if (do_r) rreg = *(const v4u*)(rg + (size_t)(t + 1) * 2048); }
        f32x16 p0 = negm, p1 = negm;
#pragma unroll
        for (int d0 = 0; d0 < 6; ++d0) {
            const bf16x8 b0 = *(const LAS bf16x8*)(lds + cur + koff + d0 * 2048), b1 = *(const LAS bf16x8*)(lds + cur + koff + d0 * 2048 + 512);
            p0 = __builtin_amdgcn_mfma_f32_32x32x16_bf16(b0, qr[d0], p0, 0, 0, 0);
            p1 = __builtin_amdgcn_mfma_f32_32x32x16_bf16(b1, qr[d0], p1, 0, 0, 0);
        }
        float rm = fmaxf(p0[0], p1[0]);
#pragma unroll
        for (int r = 1; r < 16; ++r) rm = fmaxf(rm, fmaxf(p0[r], p1[r]));
        { auto rr = __builtin_amdgcn_permlane32_swap(__float_as_uint(rm), __float_as_uint(rm), false, false); rm = fmaxf(__uint_as_float(rr[0]), __uint_as_float(rr[1])); }
        if (t == 0) {
            mhat = rm;
#pragma unroll
            for (int r = 0; r < 16; ++r) { p0[r] -= rm; p1[r] -= rm; negm[r] = -mhat; }
        } else if (__any(rm > (float)THR)) {
            const float dl = fmaxf(rm, 0.f); mhat += dl;
#pragma unroll
            for (int r = 0; r < 16; ++r) { p0[r] -= dl; p1[r] -= dl; negm[r] = -mhat; }
            const float f = __builtin_amdgcn_exp2f(-dl); l *= f;
            if (hi == 0) wsf[r32] = f;
            asm volatile("s_waitcnt lgkmcnt(0)" ::: "memory");
#pragma unroll
            for (int r = 0; r < 16; ++r) { const float fr = wsf[crow(r, hi)]; o0[r] *= fr; o1[r] *= fr; }
            asm volatile("s_waitcnt lgkmcnt(0)" ::: "memory");
        }
        float s = 0.f;
#pragma unroll
        for (int r = 0; r < 16; ++r) { p0[r] = __builtin_amdgcn_exp2f(p0[r]); p1[r] = __builtin_amdgcn_exp2f(p1[r]); s += p0[r] + p1[r]; }
        l += s;
        v4u pw[4];
        pw[0] = (v4u){cvtpk(p0[0], p0[1]), cvtpk(p0[2], p0[3]), cvtpk(p0[4], p0[5]), cvtpk(p0[6], p0[7])};
        pw[1] = (v4u){cvtpk(p0[8], p0[9]), cvtpk(p0[10], p0[11]), cvtpk(p0[12], p0[13]), cvtpk(p0[14], p0[15])};
        pw[2] = (v4u){cvtpk(p1[0], p1[1]), cvtpk(p1[2], p1[3]), cvtpk(p1[4], p1[5]), cvtpk(p1[6], p1[7])};
        pw[3] = (v4u){cvtpk(p1[8], p1[9]), cvtpk(p1[10], p1[11]), cvtpk(p1[12], p1[13]), cvtpk(p1[14], p1[15])};
#pragma unroll
        for (int ks = 0; ks < 4; ++ks) {
            const s16x4 a_lo = __builtin_bit_cast(s16x4, __builtin_amdgcn_ds_read_tr16_b64_v4i16((LAS v4i16_t*)(lds + cur + voff + ks * 1024)));
            const s16x4 a_hi = __builtin_bit_cast(s16x4, __builtin_amdgcn_ds_read_tr16_b64_v4i16((LAS v4i16_t*)(lds + cur + voff + ks * 1024 + 512)));
            const s16x4 b_lo = __builtin_bit_cast(s16x4, __builtin_amdgcn_ds_read_tr16_b64_v4i16((LAS v4i16_t*)(lds + cur + voff + 4096 + ks * 1024)));
            const s16x4 b_hi = __builtin_bit_cast(s16x4, __builtin_amdgcn_ds_read_tr16_b64_v4i16((LAS v4i16_t*)(lds + cur + voff + 4096 + ks * 1024 + 512)));
            const bf16x8 va = (bf16x8){a_lo[0], a_lo[1], a_lo[2], a_lo[3], a_hi[0], a_hi[1], a_hi[2], a_hi[3]};
            const bf16x8 vb = (bf16x8){b_lo[0], b_lo[1], b_lo[2], b_lo[3], b_hi[0], b_hi[1], b_hi[2], b_hi[3]};
            o0 = __builtin_amdgcn_mfma_f32_32x32x16_bf16(__builtin_bit_cast(bf16x8, pw[ks]), va, o0, 0, 0, 0);
            o1 = __builtin_amdgcn_mfma_f32_32x32x16_bf16(__builtin_bit_cast(bf16x8, pw[ks]), vb, o1, 0, 0, 0);
        }
        if (more) { *(LAS v4u*)(lds + nxt + kdst) = kreg; *(LAS v4u*)(lds + nxt + vdst) = vreg; if (do_r) *(LAS v4u*)(lds + nxt + rdst) = rreg; }
        __syncthreads();
    }
    { auto rr = __builtin_amdgcn_permlane32_swap(__float_as_uint(l), __float_as_uint(l), false, false); l = __uint_as_float(rr[0]) + __uint_as_float(rr[1]); }
    if (hi == 0) wsf[32 + r32] = l;
    asm volatile("s_waitcnt lgkmcnt(0)" ::: "memory");
    bf16* Ow = O + (size_t)(tok0 + qb * 256 + wid * 32) * 512 + h * 64 + r32;
#pragma unroll
    for (int r = 0; r < 16; ++r) { const int row = crow(r, hi); const float li = 1.0f / wsf[32 + row];
        Ow[(size_t)row * 512] = (bf16)f2bf(o0[r] * li); Ow[(size_t)row * 512 + 32] = (bf16)f2bf(o1[r] * li); }
    asm volatile("s_waitcnt lgkmcnt(0)" ::: "memory");
}
__device__ __forceinline__ void decode(int idx, int& tok0, int& nkt, int& h, int& qb) {
    if (idx < 1024) { const int pair = idx >> 6; qb = idx & 63; h = pair & 7; tok0 = (pair >> 3) * SEQ_P; nkt = SEQ_P / 64; }
    else { const int i2 = idx - 1024, pair = i2 >> 4; qb = i2 & 15; h = pair & 7; tok0 = MPROMPT + (pair >> 3) * SEQ_S; nkt = SEQ_S / 64; }
}
}

#ifndef SKIP_MLA
#define MLA_UNIT_CALL mla::unit<8>(lds, QB, KVB, KRB, MLAO, tok0, nkt, h, qb)
#else
#define MLA_UNIT_CALL (void)0
#endif
struct Args { const float* in[22]; float* out; unsigned char* ws; float inv_freq[16]; };
enum { I_XP = 0, I_XS, I_F1IN, I_F1OUT, I_LN1G, I_LN1B, I_WIN, I_BGATE, I_RPB, I_QNG, I_KVNG, I_WUQ, I_WUKV, I_WNAO, I_WMLAO, I_WOUT, I_LN2G, I_LN2B, I_F2IN, I_F2OUT, I_LN3G, I_LN3B };

#ifndef NA_SCALE
#define NA_SCALE 1.0f
#endif
#ifndef PH_LAST
#define PH_LAST 99
#endif

__global__ void __launch_bounds__(NWAVES * 64, 2) fwd_megakernel(Args a) {
    extern __shared__ __attribute__((aligned(16))) unsigned char lds_raw[];
    LAS unsigned char* lds = (LAS unsigned char*)lds_raw;
    cg::grid_group grid = cg::this_grid();
    const int G = gridDim.x, bx = blockIdx.x, NGW = G * NWAVES;
#define FRESH_IDS() int tid = threadIdx.x; asm volatile("" : "+v"(tid)); const int lane = tid & 63, wave = __builtin_amdgcn_readfirstlane(tid >> 6), gw = bx * NWAVES + wave; (void)lane; (void)gw
    unsigned char* ws = a.ws;
    bf16 *W1in = (bf16*)(ws + WS_W1IN), *W1out = (bf16*)(ws + WS_W1OUT), *W2in = (bf16*)(ws + WS_W2IN), *W2out = (bf16*)(ws + WS_W2OUT), *Win = (bf16*)(ws + WS_WIN), *Wg = (bf16*)(ws + WS_WG),
         *Wuq = (bf16*)(ws + WS_WUQ), *Wukv = (bf16*)(ws + WS_WUKV), *Wnao = (bf16*)(ws + WS_WNAO), *Wmlao = (bf16*)(ws + WS_WMLAO), *Wout = (bf16*)(ws + WS_WOUT);
    float* cosT = (float*)(ws + WS_ROPE); float* sinT = cosT + 16384 * 16;
    bf16* XB = (bf16*)(ws + WS_XB);
    unsigned char* R = ws + WS_R;
    bf16 *ACT = (bf16*)(R + R_ACT), *NAQKV = (bf16*)(R + R_NAQKV), *CB = (bf16*)(R + R_C), *QB = (bf16*)(R + R_Q), *MLAO = (bf16*)(R + R_MLAO), *NAO = (bf16*)(R + R_NAO),
         *KVB = (bf16*)(R + R_KV), *KRB = (bf16*)(R + R_KR), *GB = (bf16*)(R + R_G), *TB = (bf16*)(R + R_T);
    float* out = a.out;
#define GRID_SYNC() do { __threadfence(); grid.sync(); __builtin_amdgcn_fence(__ATOMIC_ACQUIRE, "agent"); } while (0)

    {
        FRESH_IDS();
        LAS float* scr = (LAS float*)(lds + wave * 16384);
        constexpr int I_FIN = 16 * 176, I_FOUT = 44 * 32, I_MIN = 16 * 133, I_UQ = 6 * 24, I_UKV = 4 * 32, I_O512 = 8 * 32, I_O1024 = 16 * 32;
        constexpr int NITEMS = 2 * I_FIN + 2 * I_FOUT + I_MIN + I_UQ + I_UKV + 2 * I_O512 + I_O1024;
        for (int it = gw; it < NITEMS; it += NGW) {
            int r = it;
            if (r < 2 * I_FIN) { const int which = r / I_FIN; r -= which * I_FIN; const int kb = r / 176, nb = r % 176; const int c0 = 32 * nb, s = c0 / DFF, j0 = c0 % DFF;
                p0_transpose_item(a.in[which ? I_F2IN : I_F1IN], DM, 2 * DFF, which ? W2in : W1in, 256 * (j0 / 128) + 128 * s + (j0 % 128), scr, kb, nb, lane); continue; }
            r -= 2 * I_FIN;
            if (r < 2 * I_FOUT) { const int which = r / I_FOUT; r -= which * I_FOUT; const int kb = r / 32, nb = r % 32;
                p0_transpose_item(a.in[which ? I_F2OUT : I_F1OUT], DFF, DM, which ? W2out : W1out, 32 * nb, scr, kb, nb, lane); continue; }
            r -= 2 * I_FOUT;
            if (r < I_MIN) { const int kb = r / 133, nb = r % 133; const int c0 = 32 * nb; bf16* dst = Win; int drow;
                if (c0 < 1536) drow = c0; else if (c0 < 1920) drow = 1536 + 256 + (c0 - 1536); else if (c0 < 2176) drow = 1536 + (c0 - 1920); else if (c0 < 2208) drow = 1536 + 640; else { dst = Wg; drow = c0 - 2208; }
                p0_transpose_item(a.in[I_WIN], DM, 4256, dst, drow, scr, kb, nb, lane); continue; }
            r -= I_MIN;
            if (r < I_UQ) { const int kb = r / 24, nb = r % 24; const int hh = nb / 3, part = nb % 3; const int drow = part < 2 ? hh * 64 + 32 * part : 512 + hh * 32;
                p0_transpose_item(a.in[I_WUQ], 384, 768, Wuq, drow, scr, kb, nb, lane); continue; }
            r -= I_UQ;
            if (r < I_UKV) { const int kb = r / 32, nb = r % 32; const int hh = nb / 4, part = nb % 4; const int drow = part < 2 ? hh * 64 + 32 * part : 512 + hh * 64 + 32 * (part - 2);
                p0_transpose_item(a.in[I_WUKV], 256, 1024, Wukv, drow, scr, kb, nb, lane); continue; }
            r -= I_UKV;
            if (r < 2 * I_O512) { const int which = r / I_O512; r -= which * I_O512; const int kb = r / 32, nb = r % 32;
                p0_transpose_item(a.in[which ? I_WMLAO : I_WNAO], 512, DM, which ? Wmlao : Wnao, 32 * nb, scr, kb, nb, lane); continue; }
            r -= 2 * I_O512;
            { const int kb = r / 32, nb = r % 32; p0_transpose_item(a.in[I_WOUT], DM, DM, Wout, 32 * nb, scr, kb, nb, lane); }
        }
        const int gt = bx * (NWAVES * 64) + tid, NGT = G * NWAVES * 64;
        for (int i = gt; i < 96 * 1024 * 2 / 16; i += NGT) ((v4u*)(Win + (size_t)2208 * 1024))[i] = (v4u){0u, 0u, 0u, 0u};
        for (int i = gt; i < 16384 * 16; i += NGT) { const int pos = i >> 4, k = i & 15; const float ang = (float)pos * a.inv_freq[k];
            const double rev = (double)ang * 0.15915494309189535; const float fr = (float)(rev - floor(rev));
            cosT[i] = __builtin_amdgcn_cosf(fr); sinT[i] = __builtin_amdgcn_sinf(fr); }
        rows_phase<false, false, true>(a.in[I_XP], nullptr, XB, nullptr, nullptr, 0, MPROMPT, gw, NGW, lane);
        rows_phase<false, false, true>(a.in[I_XS], nullptr, XB, nullptr, nullptr, MPROMPT, MTOK, gw, NGW, lane);
    }
    GRID_SYNC();
#define FFN_BLOCK(WIN_, WOUT_, BASE0_, BASE1_, SPLIT_, LNG_, LNB_, WBF_) do { \
        { pg8::Gemm g{XB, WIN_, MTOK, 2 * DFF, DM, DM}; pg8::StaticOrder S; S.init(MTOK, 2 * DFF, G, bx); pg8::EpiSwiGLU E{ACT, DFF}; \
          pg8::gemm_phase<pg8::EpiSwiGLU, pg8::StaticOrder, true, true>(lds, g, S, E); } \
        GRID_SYNC(); \
        { pg8::Gemm g{ACT, WOUT_, MTOK, DM, DFF, DFF}; pg8::StaticOrder S; S.init(MTOK, DM, G, bx); pg8::EpiResid E{BASE0_, BASE1_, SPLIT_, out, ALPHA, 0.5f}; \
          pg8::gemm_phase<pg8::EpiResid, pg8::StaticOrder, true, true>(lds, g, S, E); } \
        GRID_SYNC(); \
        { FRESH_IDS(); rows_phase<true, true, WBF_>(out, out, XB, LNG_, LNB_, 0, MTOK, gw, NGW, lane); } \
    } while (0)

    FFN_BLOCK(W1in, W1out, a.in[I_XP], a.in[I_XS] - (size_t)MPROMPT * DM, MPROMPT / 256, a.in[I_LN1G], a.in[I_LN1B], true);
    GRID_SYNC();
    { pg8::Gemm g{XB, Win, MTOK, 2304, DM, DM}; pg8::StaticOrder S; S.init(MTOK, 2304, G, bx); pg8::EpiBf16<0> E{NAQKV, 1536, 6, CB, 768, nullptr};
      pg8::gemm_phase<pg8::EpiBf16<0>, pg8::StaticOrder, true, true>(lds, g, S, E); }
    GRID_SYNC();
    { FRESH_IDS(); prep_phase(CB, KRB + 0, a.in[I_QNG], a.in[I_KVNG], cosT, sinT, gw, NGW, lane); }
    { FRESH_IDS();
    for (int ub = bx; ub < MTOK / 16; ub += G) {
        const int tok = 16 * ub; int seq0, rows;
        if (tok < MPROMPT) { seq0 = (tok / SEQ_P) * SEQ_P; rows = SEQ_P / 64; } else { seq0 = MPROMPT + ((tok - MPROMPT) / SEQ_S) * SEQ_S; rows = SEQ_S / 64; }
        const int pos = tok - seq0;
#ifndef SKIP_NA
        na_task(lds + wave * 4608, NAQKV, NAO, a.in[I_RPB], seq0, rows, pos >> 6, (pos & 63) >> 4, wave, lane);
#endif
    } }
    GRID_SYNC();
    { pg8::Gemm g{CB + 256, Wuq, MTOK, 768, 384, 768}; pg8::StaticOrder S; S.init(MTOK, 768, G, bx); pg8::EpiQRope E{QB, cosT, sinT, QSCALE};
      pg8::gemm_phase<pg8::EpiQRope, pg8::StaticOrder, true, true>(lds, g, S, E); }
    { pg8::Gemm g{CB, Wukv, MTOK, 1024, 256, 768}; pg8::StaticOrder S; S.init(MTOK, 1024, G, bx); pg8::EpiBf16<0> E{KVB, 1024, 99, nullptr, 0, nullptr};
      pg8::gemm_phase<pg8::EpiBf16<0>, pg8::StaticOrder, true, true>(lds, g, S, E); }
    GRID_SYNC();
    {
        if (G == 256) {
            const int xcd = bx & 7, l = bx >> 3;
            for (int i = 0; i < 12; ++i) {
                int idx;
                if (i < 4) { const int pair = xcd + 8 * (i >> 1), qb = 2 * l + (i & 1); idx = pair * 64 + qb; }
                else { const int u = (i - 4) * 32 + l; const int pair = xcd + 8 * (u >> 4); idx = 1024 + pair * 16 + (u & 15); }
                int tok0, nkt, h, qb; mla::decode(idx, tok0, nkt, h, qb);
                MLA_UNIT_CALL;
            }
        } else {
            for (int idx = bx; idx < 3072; idx += G) { int tok0, nkt, h, qb; mla::decode(idx, tok0, nkt, h, qb); MLA_UNIT_CALL; }
        }
    }
    GRID_SYNC();
    { pg8::Gemm g{XB, Wg, MTOK, 2048, DM, DM}; pg8::StaticOrder S; S.init(MTOK, 2048, G, bx); pg8::EpiBf16<1> E{GB, 2048, 99, nullptr, 0, a.in[I_BGATE]};
      pg8::gemm_phase<pg8::EpiBf16<1>, pg8::StaticOrder, true, true>(lds, g, S, E); }
    GRID_SYNC();
    { pg8::Gemm g{NAO, Wnao, MTOK, DM, 512, 512}; pg8::StaticOrder S; S.init(MTOK, DM, G, bx); pg8::EpiGateMul<0> E{GB, 2048, TB, NA_SCALE};
      pg8::gemm_phase<pg8::EpiGateMul<0>, pg8::StaticOrder, true, true>(lds, g, S, E); }
    __syncthreads();
#ifndef NO_MLA_BRANCH
    { pg8::Gemm g{MLAO, Wmlao, MTOK, DM, 512, 512}; pg8::StaticOrder S; S.init(MTOK, DM, G, bx); pg8::EpiGateMul<1> E{GB + 1024, 2048, TB, 1.0f};
      pg8::gemm_phase<pg8::EpiGateMul<1>, pg8::StaticOrder, true, true>(lds, g, S, E); }
#endif
    GRID_SYNC();
    { pg8::Gemm g{TB, Wout, MTOK, DM, DM, DM}; pg8::StaticOrder S; S.init(MTOK, DM, G, bx); pg8::EpiResid E{out, out, 0, out, ALPHA, 1.0f};
      pg8::gemm_phase<pg8::EpiResid, pg8::StaticOrder, true, true>(lds, g, S, E); }
    GRID_SYNC();
    { FRESH_IDS(); rows_phase<true, true, true>(out, out, XB, a.in[I_LN2G], a.in[I_LN2B], 0, MTOK, gw, NGW, lane); }
    GRID_SYNC();
    FFN_BLOCK(W2in, W2out, out, out, 0, a.in[I_LN3G], a.in[I_LN3B], false);
}

extern "C" void kernel_launch(void* const* d_in, const int* in_sizes, int n_in, void* d_out, int out_size, void* d_ws, size_t ws_size, hipStream_t stream) {
    static int grid = 0;
    if (grid == 0) {
        if (n_in != 22 || out_size != MTOK * DM || ws_size < WS_END) { fprintf(stderr, "kernel_launch: unexpected shapes (n_in %d, out %d, ws %zu)\n", n_in, out_size, ws_size); grid = -1; return; }
        int dev = 0, cus = 0, per_cu = 0;
        hipGetDevice(&dev); hipDeviceGetAttribute(&cus, hipDeviceAttributeMultiprocessorCount, dev);
        hipFuncSetAttribute((const void*)fwd_megakernel, hipFuncAttributeMaxDynamicSharedMemorySize, LDS_BYTES);
        hipOccupancyMaxActiveBlocksPerMultiprocessor(&per_cu, (const void*)fwd_megakernel, NWAVES * 64, LDS_BYTES);
        if (per_cu < 1) per_cu = 1;
        (void)hipGetLastError();
        grid = cus * per_cu;
    }
    if (grid < 0) return;
    Args a{};
    for (int i = 0; i < 22; ++i) a.in[i] = (const float*)d_in[i];
    a.out = (float*)d_out; a.ws = (unsigned char*)d_ws;
    for (int i = 0; i < 16; ++i) a.inv_freq[i] = 1.0f / powf(10000.0f, (float)(2 * i) / 32.0f);
    void* args[] = {&a};
    hipError_t e = hipLaunchCooperativeKernel((const void*)fwd_megakernel, dim3(grid), dim3(NWAVES * 64), args, LDS_BYTES, stream);
    if (e != hipSuccess) fprintf(stderr, "cooperative launch failed: %s (grid %d)\n", hipGetErrorString(e), grid);
}
```

```cpp
#include <hip/hip_runtime.h>
#include <hip/hip_cooperative_groups.h>
#include <cstdio>
#include <cstdint>
#include <cmath>
namespace cg = cooperative_groups;
namespace pg8 {
#define PG8_LAS __attribute__((address_space(3)))
typedef unsigned short bf16_t;
typedef short bf16x8 __attribute__((ext_vector_type(8)));
typedef float f32x4 __attribute__((ext_vector_type(4)));
typedef unsigned u32x4 __attribute__((ext_vector_type(4)));
constexpr int BM = 256, BK = 64, HALF = 128, HTB = HALF * BK * 2  , STAGE_BYTES = 8 * HTB, NXCD = 8, WGM = 8;

__host__ __device__ __forceinline__ int lds_byte(int r, int c) { const int st = (r >> 4) * 2 + (c >> 5), rr = r & 15, cc = c & 31, ob = rr * 64 + cc * 2; return st * 1024 + (ob ^ (((ob >> 9) & 1) << 5)); }
__host__ __device__ __forceinline__ void stage_rc(int b, int& R, int& C) { const int st = b / 1024, sb = b % 1024, swz = sb ^ (((sb >> 9) & 1) << 5); R = (st >> 1) * 16 + swz / 64; C = (st & 1) * 32 + (swz % 64) / 2; }
__host__ __device__ __forceinline__ int perm32(int rho) { const int n = rho >> 4, i = rho & 15; return 8 * (i >> 2) + 4 * n + (i & 3); }

struct Unit { int pm, pn; };
struct Gemm { const bf16_t* A; const bf16_t* Bt; int M, N, K, lda; };

struct StaticOrder {
    int nM, nN, nwg, G, c;
    __host__ __device__ void init(int M, int N, int G_, int c_) { nM = M / BM; nN = N / BM; nwg = nM * nN; G = G_; c = c_; }
    __host__ __device__ bool next(int i, Unit& u) const {
        const long L = (long)i * G + c; if (L >= nwg) return false;
        int wgid = (int)L; { const int q = nwg / NXCD, r = nwg % NXCD, xcd = wgid % NXCD, off = wgid / NXCD; wgid = (xcd < r ? xcd * (q + 1) : r * (q + 1) + (xcd - r) * q) + off; }
        const int nig = WGM * nN, gid = wgid / nig, fm = gid * WGM, gsz = (nM - fm) < WGM ? (nM - fm) : WGM;
        u.pm = fm + ((wgid % nig) % gsz); u.pn = (wgid % nig) / gsz; return true;
    }
    __device__ __forceinline__ void a_ready(const Unit&) const {}
    __device__ __forceinline__ void done(const Unit&) const {}
};


typedef unsigned u32x2 __attribute__((ext_vector_type(2)));
typedef float f32x2_t __attribute__((ext_vector_type(2))); typedef __bf16 bf16x2_t __attribute__((ext_vector_type(2)));
__device__ __forceinline__ unsigned cvt_pk_bf16(float lo, float hi) { f32x2_t v = {lo, hi}; bf16x2_t b = __builtin_convertvector(v, bf16x2_t); return __builtin_bit_cast(unsigned, b); }
__device__ __forceinline__ float bf_lo(unsigned w) { return __uint_as_float(w << 16); }
__device__ __forceinline__ float bf_hi(unsigned w) { return __uint_as_float(w & 0xffff0000u); }
__device__ __forceinline__ float fsigmoid(float x) { return __builtin_amdgcn_rcpf(1.0f + __builtin_amdgcn_exp2f(-1.4426950408889634f * x)); }

struct EpiSwiGLU {
    static constexpr bool PERM = true, AFTER_DRAIN = false;
    bf16_t* O; int ldc;
    __device__ __forceinline__ void operator()(const f32x4 (&acc)[2][2][4][2], const Unit& u, int wr, int wc, int fr, int fq) const {
        const int row0 = u.pm * BM + wr * 64 + fr, col0 = u.pn * HALF + wc * 32 + 8 * fq;
#pragma unroll
        for (int ai = 0; ai < 2; ++ai)
#pragma unroll
            for (int m = 0; m < 4; ++m) { bf16_t* rowp = O + (size_t)(row0 + ai * HALF + m * 16) * ldc + col0;
                f32x4 h0, h1;
#pragma unroll
                for (int e = 0; e < 4; ++e) { const float a0 = acc[ai][0][m][0][e], a1 = acc[ai][0][m][1][e];
                    h0[e] = a0 * fsigmoid(a0) * acc[ai][1][m][0][e]; h1[e] = a1 * fsigmoid(a1) * acc[ai][1][m][1][e]; }
                u32x4 w; w.x = cvt_pk_bf16(h0[0], h0[1]); w.y = cvt_pk_bf16(h0[2], h0[3]); w.z = cvt_pk_bf16(h1[0], h1[1]); w.w = cvt_pk_bf16(h1[2], h1[3]);
                *(u32x4*)rowp = w; }
    }
};
struct EpiResid {
    static constexpr bool PERM = false, AFTER_DRAIN = false;
    const float* base0; const float* base1; int split_pm; float* out; float alpha, s;
    __device__ __forceinline__ void operator()(const f32x4 (&acc)[2][2][4][2], const Unit& u, int wr, int wc, int fr, int fq) const {
        const int row0 = u.pm * BM + wr * 64 + fr, col0 = u.pn * BM + wc * 32 + 4 * fq;
        const float* base = (u.pm < split_pm) ? base0 : base1;
#pragma unroll
        for (int ai = 0; ai < 2; ++ai)
#pragma unroll
            for (int m = 0; m < 4; ++m) { const size_t off = (size_t)(row0 + ai * HALF + m * 16) * 1024 + col0;
#pragma unroll
                for (int bj = 0; bj < 2; ++bj)
#pragma unroll
                    for (int n = 0; n < 2; ++n) { const f32x4 b = *(const f32x4*)(base + off + bj * HALF + n * 16);
                        const f32x4 o = b * alpha + acc[ai][bj][m][n] * s; *(f32x4*)(out + off + bj * HALF + n * 16) = o; }
                asm volatile("" ::: "memory"); }
    }
};
template <int ACT> struct EpiBf16 {
    static constexpr bool PERM = true, AFTER_DRAIN = false;
    bf16_t* O0; int ld0; int nsplit; bf16_t* O1; int ld1; const float* bias;
    __device__ __forceinline__ void operator()(const f32x4 (&acc)[2][2][4][2], const Unit& u, int wr, int wc, int fr, int fq) const {
        bf16_t* base; int ld, colt;
        if (u.pn < nsplit) { base = O0; ld = ld0; colt = u.pn * BM; } else { base = O1; ld = ld1; colt = (u.pn - nsplit) * BM; }
        const int row0 = u.pm * BM + wr * 64 + fr, col0 = colt + wc * 32 + 8 * fq, bcol0 = u.pn * BM + wc * 32 + 8 * fq;
        f32x4 bv[2][2];
#pragma unroll
        for (int bj = 0; bj < 2; ++bj)
#pragma unroll
            for (int n = 0; n < 2; ++n) bv[bj][n] = ACT ? *(const f32x4*)(bias + bcol0 + bj * HALF + 4 * n) : (f32x4){0.f, 0.f, 0.f, 0.f};
#pragma unroll
        for (int ai = 0; ai < 2; ++ai)
#pragma unroll
            for (int m = 0; m < 4; ++m) { bf16_t* rowp = base + (size_t)(row0 + ai * HALF + m * 16) * ld + col0;
#pragma unroll
                for (int bj = 0; bj < 2; ++bj) { f32x4 v0 = acc[ai][bj][m][0], v1 = acc[ai][bj][m][1];
                    if (ACT) { v0 = v0 + bv[bj][0]; v1 = v1 + bv[bj][1];
#pragma unroll
                        for (int e = 0; e < 4; ++e) { v0[e] = fsigmoid(v0[e]); v1[e] = fsigmoid(v1[e]); } }
                    u32x4 w; w.x = cvt_pk_bf16(v0[0], v0[1]); w.y = cvt_pk_bf16(v0[2], v0[3]); w.z = cvt_pk_bf16(v1[0], v1[1]); w.w = cvt_pk_bf16(v1[2], v1[3]);
                    *(u32x4*)(rowp + bj * HALF) = w; } }
    }
};
template <int ACCUM> struct EpiGateMul {
    static constexpr bool PERM = true, AFTER_DRAIN = false;
    const bf16_t* G; int ldg; bf16_t* T; float sc;
    __device__ __forceinline__ void operator()(const f32x4 (&acc)[2][2][4][2], const Unit& u, int wr, int wc, int fr, int fq) const {
        const int row0 = u.pm * BM + wr * 64 + fr, col0 = u.pn * BM + wc * 32 + 8 * fq;
#pragma unroll
        for (int ai = 0; ai < 2; ++ai)
#pragma unroll
            for (int m = 0; m < 4; ++m) { const size_t row = (size_t)(row0 + ai * HALF + m * 16);
#pragma unroll
                for (int bj = 0; bj < 2; ++bj) { const u32x4 g = *(const u32x4*)(G + row * ldg + col0 + bj * HALF);
                    u32x4 t = (u32x4){0u, 0u, 0u, 0u}; if (ACCUM) t = *(const u32x4*)(T + row * 1024 + col0 + bj * HALF);
                    const f32x4 v0 = acc[ai][bj][m][0] * sc, v1 = acc[ai][bj][m][1] * sc;
                    u32x4 w;
                    w.x = cvt_pk_bf16(bf_lo(t.x) + bf_lo(g.x) * v0[0], bf_hi(t.x) + bf_hi(g.x) * v0[1]);
                    w.y = cvt_pk_bf16(bf_lo(t.y) + bf_lo(g.y) * v0[2], bf_hi(t.y) + bf_hi(g.y) * v0[3]);
                    w.z = cvt_pk_bf16(bf_lo(t.z) + bf_lo(g.z) * v1[0], bf_hi(t.z) + bf_hi(g.z) * v1[1]);
                    w.w = cvt_pk_bf16(bf_lo(t.w) + bf_lo(g.w) * v1[2], bf_hi(t.w) + bf_hi(g.w) * v1[3]);
                    *(u32x4*)(T + row * 1024 + col0 + bj * HALF) = w; asm volatile("" ::: "memory"); } }
    }
};
struct EpiQRope {
    static constexpr bool PERM = false, AFTER_DRAIN = false;
    bf16_t* Q; const float* cosT; const float* sinT; float qscale;
    __device__ __forceinline__ void operator()(const f32x4 (&acc)[2][2][4][2], const Unit& u, int wr, int wc, int fr, int fq) const {
        const int row0 = u.pm * BM + wr * 64 + fr;
        if (u.pn < 2) {
            const int col0 = u.pn * BM + wc * 32 + 4 * fq;
#pragma unroll
            for (int ai = 0; ai < 2; ++ai)
#pragma unroll
                for (int m = 0; m < 4; ++m) { bf16_t* rowp = Q + (size_t)(row0 + ai * HALF + m * 16) * 768 + col0;
#pragma unroll
                    for (int bj = 0; bj < 2; ++bj)
#pragma unroll
                        for (int n = 0; n < 2; ++n) { const f32x4 v = acc[ai][bj][m][n] * qscale; u32x2 w; w.x = cvt_pk_bf16(v[0], v[1]); w.y = cvt_pk_bf16(v[2], v[3]);
                            *(u32x2*)(rowp + bj * HALF + n * 16) = w; } }
        } else {
#pragma unroll
            for (int ai = 0; ai < 2; ++ai)
#pragma unroll
                for (int m = 0; m < 4; ++m) { const int row = row0 + ai * HALF + m * 16; const int pos = row < 32768 ? (row & 16383) : (row & 4095);
                    const f32x4 cs = *(const f32x4*)(cosT + pos * 16 + 4 * fq), sn = *(const f32x4*)(sinT + pos * 16 + 4 * fq);
                    bf16_t* rowp = Q + (size_t)row * 768 + 512 + 4 * fq;
#pragma unroll
                    for (int bj = 0; bj < 2; ++bj) { const f32x4 x1 = acc[ai][bj][m][0], x2 = acc[ai][bj][m][1];
                        const f32x4 o1 = (x1 * cs - x2 * sn) * qscale, o2 = (x1 * sn + x2 * cs) * qscale; const int head = 4 * bj + wc;
                        u32x2 w1, w2; w1.x = cvt_pk_bf16(o1[0], o1[1]); w1.y = cvt_pk_bf16(o1[2], o1[3]); w2.x = cvt_pk_bf16(o2[0], o2[1]); w2.y = cvt_pk_bf16(o2[2], o2[3]);
                        *(u32x2*)(rowp + head * 32) = w1; *(u32x2*)(rowp + head * 32 + 16) = w2; }
                    asm volatile("" ::: "memory"); }
        }
    }
};

template <class Epi, class Sched, bool ALIGN_EPI = false, bool SP2 = false>
__device__ __forceinline__ void gemm_phase(PG8_LAS unsigned char* lds, const Gemm g, const Sched& S, const Epi& E) {
    int tid_raw = threadIdx.x; asm volatile("" : "+v"(tid_raw));
    const int tid = tid_raw, wid = __builtin_amdgcn_readfirstlane(tid >> 6), lane = tid & 63, wr = wid >> 2, wc = wid & 3, fr = lane & 15, fq = lane >> 4;
    int K_raw = g.K; asm volatile("" : "+s"(K_raw));
    const int K = K_raw, nt = K / BK;
    unsigned voffA[2], voffB[2];
#pragma unroll
    for (int i = 0; i < 2; ++i) { int R, C; stage_rc(tid * 16 + i * 8192, R, C); const int Rb = Epi::PERM ? ((R & ~31) + perm32(R & 31)) : R;
        voffA[i] = (unsigned)(R * g.lda + C) * 2u; voffB[i] = (unsigned)(Rb * K + C) * 2u; }
    const size_t kstep = (size_t)(BK * 2);
    const size_t hstepB = (size_t)HALF * K * 2, hstepA = (size_t)HALF * g.lda * 2;
    const size_t tstepA = 2 * hstepA, tstepB = 2 * hstepB;
    const unsigned ldsw = (unsigned)wid * 1024u;
    const int aoff = lds_byte(wr * 64 + fr, fq * 8), boff = lds_byte(wc * 32 + fr, fq * 8);
#define PG8_SA(b, h) (((b) * 2 + (h)) * HTB)
#define PG8_SB(b, h) ((4 + (b) * 2 + (h)) * HTB)
#define PG8_STAGE(bufoff, gbase, voff) do { _Pragma("unroll") for (int _i = 0; _i < 2; ++_i) \
        __builtin_amdgcn_global_load_lds((const unsigned*)((const char*)(gbase) + (voff)[_i]), (PG8_LAS unsigned*)(lds + (bufoff) + ldsw + _i * 8192), 16, 0, 0); } while (0)
#define PG8_LDA(dst, b, h) do { _Pragma("unroll") for (int m = 0; m < 4; ++m) _Pragma("unroll") for (int k = 0; k < 2; ++k) dst[m][k] = *(const PG8_LAS bf16x8*)(lds + PG8_SA(b, h) + aoff + m * 2048 + k * 1024); } while (0)
#define PG8_LDB(dst, b, h) do { _Pragma("unroll") for (int n = 0; n < 2; ++n) _Pragma("unroll") for (int k = 0; k < 2; ++k) dst[n][k] = *(const PG8_LAS bf16x8*)(lds + PG8_SB(b, h) + boff + n * 2048 + k * 1024); } while (0)
#define PG8_MMA(ai, bj, At, Bt) do { __builtin_amdgcn_s_setprio(1); _Pragma("unroll") for (int m = 0; m < 4; ++m) _Pragma("unroll") for (int n = 0; n < 2; ++n) _Pragma("unroll") for (int k = 0; k < 2; ++k) \
        acc[ai][bj][m][n] = __builtin_amdgcn_mfma_f32_16x16x32_bf16(Bt[n][k], At[m][k], acc[ai][bj][m][n], 0, 0, 0); __builtin_amdgcn_s_setprio(0); } while (0)
#define PG8_WAIT_V(n) asm volatile("s_waitcnt vmcnt(" #n ")" ::: "memory")
#define PG8_WAIT_L(n) asm volatile("s_waitcnt lgkmcnt(" #n ")" ::: "memory")
#define PG8_BAR __builtin_amdgcn_s_barrier()
#define PG8_SCHED __builtin_amdgcn_sched_barrier(0)
    Unit cur, nxt; int ui = 0;
    if (!S.next(0, cur)) return;
    f32x4 acc[2][2][4][2];
#pragma unroll
    for (int a = 0; a < 2; ++a)
#pragma unroll
        for (int b = 0; b < 2; ++b)
#pragma unroll
            for (int m = 0; m < 4; ++m)
#pragma unroll
                for (int n = 0; n < 2; ++n) acc[a][b][m][n] = (f32x4){0.f, 0.f, 0.f, 0.f};
    bf16x8 At[4][2], B0[2][2], B1[2][2];
    const char* cA = (const char*)g.A + (size_t)cur.pm * tstepA; const char* cB = (const char*)g.Bt + (size_t)cur.pn * tstepB;
    S.a_ready(cur);
    if constexpr (SP2) {
        PG8_STAGE(PG8_SB(0, 0), cB, voffB); PG8_STAGE(PG8_SB(0, 1), cB + hstepB, voffB); PG8_STAGE(PG8_SA(0, 0), cA, voffA); PG8_STAGE(PG8_SA(0, 1), cA + hstepA, voffA);
        if (wr == 1) PG8_BAR;
        PG8_WAIT_V(2); PG8_BAR;
        PG8_STAGE(PG8_SB(1, 0), cB + kstep, voffB); PG8_STAGE(PG8_SA(1, 0), cA + kstep, voffA); PG8_STAGE(PG8_SB(1, 1), cB + hstepB + kstep, voffB);
        PG8_WAIT_V(6); PG8_BAR;
    } else {
        PG8_STAGE(PG8_SB(0, 0), cB, voffB); PG8_STAGE(PG8_SA(0, 0), cA, voffA); PG8_STAGE(PG8_SB(0, 1), cB + hstepB, voffB); PG8_STAGE(PG8_SA(0, 1), cA + hstepA, voffA);
        if (wr == 1) PG8_BAR;
        PG8_WAIT_V(4); PG8_BAR;
        PG8_STAGE(PG8_SB(1, 0), cB + kstep, voffB); PG8_STAGE(PG8_SA(1, 0), cA + kstep, voffA); PG8_STAGE(PG8_SB(1, 1), cB + hstepB + kstep, voffB);
        PG8_WAIT_V(6); PG8_BAR;
    }
    for (;;) {
        const bool has_next = S.next(ui + 1, nxt);
        const char* nA = has_next ? (const char*)g.A + (size_t)nxt.pm * tstepA : cA; const char* nB = has_next ? (const char*)g.Bt + (size_t)nxt.pn * tstepB : cB;
        for (int t = 0; t < nt; t += 2) {
            const bool last = (t == nt - 2);
            const char* a1 = cA + (size_t)(t + 1) * kstep;
            const char* a2 = last ? nA : cA + (size_t)(t + 2) * kstep; const char* b2 = last ? nB : cB + (size_t)(t + 2) * kstep;
            const char* a3 = a2 + kstep; const char* b3 = b2 + kstep;
            if (last && has_next) S.a_ready(nxt);
            if constexpr (SP2) {
            PG8_LDB(B0, 0, 0); PG8_LDB(B1, 0, 1); PG8_SCHED; PG8_LDA(At, 0, 0); PG8_STAGE(PG8_SA(1, 1), a1 + hstepA, voffA);
            PG8_WAIT_V(8); PG8_WAIT_L(0); PG8_BAR; PG8_MMA(0, 0, At, B0); PG8_MMA(0, 1, At, B1); PG8_BAR; PG8_SCHED;
            PG8_LDA(At, 0, 1); PG8_STAGE(PG8_SB(0, 0), b2, voffB); PG8_STAGE(PG8_SB(0, 1), b2 + hstepB, voffB); PG8_STAGE(PG8_SA(0, 0), a2, voffA);
            PG8_WAIT_V(8); PG8_WAIT_L(0); PG8_BAR; PG8_MMA(1, 0, At, B0); PG8_MMA(1, 1, At, B1); PG8_BAR; PG8_SCHED;
            PG8_LDB(B0, 1, 0); PG8_LDB(B1, 1, 1); PG8_SCHED; PG8_LDA(At, 1, 0); PG8_STAGE(PG8_SA(0, 1), a2 + hstepA, voffA);
            PG8_WAIT_V(8); PG8_WAIT_L(0); PG8_BAR; PG8_MMA(0, 0, At, B0); PG8_MMA(0, 1, At, B1); PG8_BAR; PG8_SCHED;
            PG8_LDA(At, 1, 1); PG8_STAGE(PG8_SB(1, 0), b3, voffB); PG8_STAGE(PG8_SB(1, 1), b3 + hstepB, voffB); PG8_STAGE(PG8_SA(1, 0), a3, voffA);
            PG8_WAIT_V(8); PG8_WAIT_L(0); PG8_BAR; PG8_MMA(1, 0, At, B0); PG8_MMA(1, 1, At, B1); PG8_BAR; PG8_SCHED;
            } else {
            PG8_LDB(B0, 0, 0); PG8_SCHED; PG8_LDA(At, 0, 0); PG8_STAGE(PG8_SA(1, 1), a1 + hstepA, voffA);
            PG8_WAIT_L(8); PG8_BAR; PG8_WAIT_L(0); PG8_MMA(0, 0, At, B0); PG8_BAR; PG8_SCHED;
            PG8_LDB(B1, 0, 1); PG8_STAGE(PG8_SB(0, 0), b2, voffB);
            PG8_BAR; PG8_WAIT_L(0); PG8_MMA(0, 1, At, B1); PG8_BAR;
            PG8_LDA(At, 0, 1); PG8_STAGE(PG8_SA(0, 0), a2, voffA);
            PG8_BAR; PG8_WAIT_L(0); PG8_MMA(1, 0, At, B0); PG8_BAR; PG8_SCHED;
            PG8_STAGE(PG8_SB(0, 1), b2 + hstepB, voffB);
            PG8_WAIT_V(6); PG8_BAR; PG8_MMA(1, 1, At, B1); PG8_BAR;
            PG8_LDB(B0, 1, 0); PG8_SCHED; PG8_LDA(At, 1, 0); PG8_STAGE(PG8_SA(0, 1), a2 + hstepA, voffA);
            PG8_WAIT_L(8); PG8_BAR; PG8_WAIT_L(0); PG8_MMA(0, 0, At, B0); PG8_BAR; PG8_SCHED;
            PG8_LDB(B1, 1, 1); PG8_STAGE(PG8_SB(1, 0), b3, voffB);
            PG8_BAR; PG8_WAIT_L(0); PG8_MMA(0, 1, At, B1); PG8_BAR;
            PG8_LDA(At, 1, 1); PG8_STAGE(PG8_SA(1, 0), a3, voffA);
            PG8_BAR; PG8_WAIT_L(0); PG8_MMA(1, 0, At, B0); PG8_BAR; PG8_SCHED;
            PG8_STAGE(PG8_SB(1, 1), b3 + hstepB, voffB);
            PG8_WAIT_V(6); PG8_BAR; PG8_MMA(1, 1, At, B1); PG8_BAR;
            }
        }
        if constexpr (ALIGN_EPI) { if (wr == 0) PG8_BAR; }
        if constexpr (!Epi::AFTER_DRAIN) { E(acc, cur, wr, wc, fr, fq); S.done(cur); }
        if (!has_next) break;
#pragma unroll
        for (int a = 0; a < 2; ++a)
#pragma unroll
            for (int b = 0; b < 2; ++b)
#pragma unroll
                for (int m = 0; m < 4; ++m)
#pragma unroll
                    for (int n = 0; n < 2; ++n) acc[a][b][m][n] = (f32x4){0.f, 0.f, 0.f, 0.f};
        cur = nxt; cA = nA; cB = nB; ++ui;
        if constexpr (ALIGN_EPI) { if (wr == 1) PG8_BAR; }
    }
    PG8_WAIT_V(0);
    if constexpr (!ALIGN_EPI) { if (wr == 0) PG8_BAR; }
    PG8_BAR;
    if constexpr (Epi::AFTER_DRAIN) { E.fused(acc, cur, wr, wc, fr, fq, lds, wid, lane); S.done(cur); }
#undef PG8_SA
#undef PG8_SB
#undef PG8_STAGE
#undef PG8_LDA
#undef PG8_LDB
#undef PG8_MMA
#undef PG8_WAIT_V
#undef PG8_WAIT_L
#undef PG8_BAR
#undef PG8_SCHED
}
}

constexpr int DM = 1024, DFF = 2816, MTOK = 98304, MPROMPT = 32768, SEQ_P = 16384, SEQ_S = 4096;
constexpr int NWAVES = 8;
constexpr float LN_EPS = 1e-5f, RMS_EPS = 1e-6f;
constexpr float ALPHA = 1.189207115002721f;
constexpr float QSCALE = 0.10206207261596575f * 1.4426950408889634f;

#define GAS __attribute__((address_space(1)))
#define LAS __attribute__((address_space(3)))
typedef unsigned short bf16;
typedef unsigned v4u __attribute__((ext_vector_type(4)));
typedef unsigned v2u __attribute__((ext_vector_type(2)));
typedef float f32x4 __attribute__((ext_vector_type(4)));
typedef float f32x16 __attribute__((ext_vector_type(16)));
typedef short bf16x8 __attribute__((ext_vector_type(8)));
typedef short s16x4 __attribute__((ext_vector_type(4)));
typedef short v4i16_t __attribute__((ext_vector_type(4)));

constexpr size_t MiB = 1u << 20;
constexpr size_t WS_W1IN = 0, WS_W1OUT = 12 * MiB, WS_W2IN = 18 * MiB, WS_W2OUT = 30 * MiB, WS_WIN = 36 * MiB, WS_WG = 41 * MiB, WS_WUQ = 45 * MiB, WS_WUKV = 46 * MiB,
                 WS_WNAO = 47 * MiB, WS_WMLAO = 48 * MiB, WS_WOUT = 49 * MiB, WS_ROPE = 52 * MiB  , WS_XB = 54 * MiB, WS_R = 246 * MiB, WS_END = 1023 * MiB;
constexpr size_t R_ACT = 0, R_NAQKV = 0  , R_C = 288 * MiB  , R_Q = 432 * MiB  , R_MLAO = 585 * MiB  , R_NAO = 681 * MiB  ,
                 R_KV = 0  , R_KR = 576 * MiB  , R_G = 0  , R_T = 384 * MiB  ;
static_assert((size_t)DM * 2 * DFF * 2 <= 12 * MiB && (size_t)DFF * DM * 2 <= 6 * MiB && 2304 * 1024 * 2 <= 5 * MiB, "weights map");
static_assert(WS_R + 777 * MiB <= WS_END && WS_XB + (size_t)MTOK * DM * 2 <= WS_R, "ws map");

constexpr int RING_BYTES = 131072, LDS_BYTES = 147456;

__device__ __forceinline__ unsigned f2bf(float f) { unsigned u = __builtin_bit_cast(unsigned, f); return (u + 0x7fffu + ((u >> 16) & 1u)) >> 16; }
__device__ __forceinline__ unsigned pk2(float lo, float hi) { return f2bf(lo) | (f2bf(hi) << 16); }
__device__ __forceinline__ float bflo(unsigned w) { return __uint_as_float(w << 16); }
__device__ __forceinline__ float bfhi(unsigned w) { return __uint_as_float(w & 0xffff0000u); }
__device__ __forceinline__ float wave_sum(float v) {
#pragma unroll
    for (int o = 1; o < 64; o <<= 1) v += __shfl_xor(v, o);
    return v;
}

__device__ __forceinline__ void p0_transpose_item(const float* W, int K, int N, bf16* WT, int dst_row0, LAS float* scr, int kb, int nb, int lane) {
    const int k0 = 64 * kb, n0 = 32 * nb;
#pragma unroll 8
    for (int i = 0; i < 32; ++i) { const int kk = 2 * i + (lane >> 5); scr[kk * 33 + (lane & 31)] = W[(size_t)(k0 + kk) * N + n0 + (lane & 31)]; }
    asm volatile("s_waitcnt lgkmcnt(0)" ::: "memory");
    const int c = lane & 7;
#pragma unroll
    for (int j = 0; j < 4; ++j) { const int n = (lane >> 3) + 8 * j; const LAS float* s = scr + (8 * c) * 33 + n;
        v4u o; o.x = pk2(s[0 * 33], s[1 * 33]); o.y = pk2(s[2 * 33], s[3 * 33]); o.z = pk2(s[4 * 33], s[5 * 33]); o.w = pk2(s[6 * 33], s[7 * 33]);
        *(v4u*)(WT + (size_t)(dst_row0 + n) * K + k0 + 8 * c) = o; }
    asm volatile("s_waitcnt lgkmcnt(0)" ::: "memory");
}

template <bool LN, bool WF32, bool WBF>
__device__ __forceinline__ void rows_phase(const float* X, float* XO, bf16* XB, const float* gam, const float* bet, int row_lo, int row_hi, int gw, int NGW, int lane) {
    f32x4 g[4], b[4];
    if (LN) {
#pragma unroll
        for (int j = 0; j < 4; ++j) { g[j] = ((const f32x4*)gam)[lane + 64 * j]; b[j] = ((const f32x4*)bet)[lane + 64 * j]; }
    }
    for (int m = row_lo + gw; m < row_hi; m += NGW) {
        const f32x4* xr = (const f32x4*)(X + (size_t)(m - row_lo) * DM) + lane;
        f32x4 v[4]; float s = 0.f;
#pragma unroll
        for (int j = 0; j < 4; ++j) { v[j] = xr[64 * j]; s += (v[j].x + v[j].y) + (v[j].z + v[j].w); }
        if (LN) {
            const float mean = wave_sum(s) * (1.f / DM); float s2 = 0.f;
#pragma unroll
            for (int j = 0; j < 4; ++j) { v[j] = v[j] - mean; s2 += (v[j].x * v[j].x + v[j].y * v[j].y) + (v[j].z * v[j].z + v[j].w * v[j].w); }
            const float rstd = 1.f / sqrtf(wave_sum(s2) * (1.f / DM) + LN_EPS);
#pragma unroll
            for (int j = 0; j < 4; ++j) v[j] = v[j] * rstd * g[j] + b[j];
        }
        if (WF32) { f32x4* xo = (f32x4*)(XO + (size_t)m * DM) + lane;
#pragma unroll
            for (int j = 0; j < 4; ++j) xo[64 * j] = v[j]; }
        if (WBF) { v2u* o8 = (v2u*)(XB + (size_t)m * DM) + lane;
#pragma unroll
            for (int j = 0; j < 4; ++j) { v2u w; w.x = pk2(v[j].x, v[j].y); w.y = pk2(v[j].z, v[j].w); o8[64 * j] = w; } }
    }
}

__device__ __forceinline__ void prep_phase(bf16* C, bf16* KR, const float* qg, const float* kvg, const float* cosT, const float* sinT, int gw, int NGW, int lane) {
    f32x4 gkv = ((const f32x4*)kvg)[lane];
    float gq[6];
#pragma unroll
    for (int k = 0; k < 3; ++k) { gq[2 * k] = qg[2 * (lane + 64 * k)]; gq[2 * k + 1] = qg[2 * (lane + 64 * k) + 1]; }
    for (int m = gw; m < MTOK; m += NGW) {
        bf16* row = C + (size_t)m * 768;
        const v2u kv = *(const v2u*)(row + 4 * lane);
        unsigned qw[3];
#pragma unroll
        for (int k = 0; k < 3; ++k) qw[k] = *(const unsigned*)(row + 256 + 2 * (lane + 64 * k));
        float x1 = 0.f, x2 = 0.f;
        if (lane < 16) { x1 = __uint_as_float((unsigned)row[640 + lane] << 16); x2 = __uint_as_float((unsigned)row[656 + lane] << 16); }
        const float a0 = bflo(kv.x), a1 = bfhi(kv.x), a2 = bflo(kv.y), a3 = bfhi(kv.y);
        const float skv = wave_sum((a0 * a0 + a1 * a1) + (a2 * a2 + a3 * a3));
        float q[6]; float sq = 0.f;
#pragma unroll
        for (int k = 0; k < 3; ++k) { q[2 * k] = bflo(qw[k]); q[2 * k + 1] = bfhi(qw[k]); sq += q[2 * k] * q[2 * k] + q[2 * k + 1] * q[2 * k + 1]; }
        sq = wave_sum(sq);
        const float rkv = 1.f / sqrtf(skv * (1.f / 256.f) + RMS_EPS), rq = 1.f / sqrtf(sq * (1.f / 384.f) + RMS_EPS);
        v2u okv; okv.x = pk2(a0 * rkv * gkv.x, a1 * rkv * gkv.y); okv.y = pk2(a2 * rkv * gkv.z, a3 * rkv * gkv.w);
        *(v2u*)(row + 4 * lane) = okv;
#pragma unroll
        for (int k = 0; k < 3; ++k) *(unsigned*)(row + 256 + 2 * (lane + 64 * k)) = pk2(q[2 * k] * rq * gq[2 * k], q[2 * k + 1] * rq * gq[2 * k + 1]);
        if (lane < 16) { const int pos = m < MPROMPT ? (m & (SEQ_P - 1)) : (m & (SEQ_S - 1)); const float c = cosT[pos * 16 + lane], s = sinT[pos * 16 + lane];
            KR[(size_t)m * 32 + lane] = (bf16)f2bf(x1 * c - x2 * s); KR[(size_t)m * 32 + 16 + lane] = (bf16)f2bf(x1 * s + x2 * c); }
    }
}

__device__ __forceinline__ void na_task(LAS unsigned char* ldsw, const bf16* QKV, bf16* O, const float* rpb, int seq0, int rows, int r, int j, int h, int lane) {
    const int q = lane & 15, g = lane >> 4;
    int row_start = r - 4; row_start = row_start < 0 ? 0 : (row_start > rows - 8 ? rows - 8 : row_start);
    int slab_start = 16 * j - 8; slab_start = slab_start < 0 ? 0 : (slab_start > 32 ? 32 : slab_start);
    const int qcol = 16 * j + q; int win_start = qcol - 8; win_start = win_start < 0 ? 0 : (win_start > 48 ? 48 : win_start);
    const bf16* qp = QKV + (size_t)(seq0 + r * 64 + qcol) * 1536 + h * 64 + g * 8;
    const bf16x8 qf0 = *(const bf16x8*)qp, qf1 = *(const bf16x8*)(qp + 32);
    f32x4 st[16];
#pragma unroll
    for (int kt = 0; kt < 16; ++kt) {
        const bf16* kp = QKV + (size_t)(seq0 + (row_start + (kt >> 1)) * 64 + slab_start + 16 * (kt & 1) + q) * 1536 + 512 + h * 64 + g * 8;
        const bf16x8 k0 = *(const bf16x8*)kp, k1 = *(const bf16x8*)(kp + 32);
        f32x4 a = (f32x4){0.f, 0.f, 0.f, 0.f};
        a = __builtin_amdgcn_mfma_f32_16x16x32_bf16(k0, qf0, a, 0, 0, 0);
        a = __builtin_amdgcn_mfma_f32_16x16x32_bf16(k1, qf1, a, 0, 0, 0);
        st[kt] = a;
    }
    const float* rp = rpb + h * (15 * 31);
    float mx = -INFINITY;
#pragma unroll
    for (int kt = 0; kt < 16; ++kt) {
        const int dr = row_start + (kt >> 1) - r + 7;
#pragma unroll
        for (int e = 0; e < 4; ++e) {
            const int scol = slab_start + 16 * (kt & 1) + 4 * g + e; int dc = scol - qcol + 15; dc = dc < 0 ? 0 : (dc > 30 ? 30 : dc);
            const bool valid = (scol >= win_start) && (scol < win_start + 16);
            float s = (st[kt][e] * 0.125f + rp[dr * 31 + dc]) * 1.4426950408889634f;
            s = valid ? s : -INFINITY; st[kt][e] = s; mx = fmaxf(mx, s);
        }
    }
    mx = fmaxf(mx, __shfl_xor(mx, 16)); mx = fmaxf(mx, __shfl_xor(mx, 32));
    float sum = 0.f;
#pragma unroll
    for (int kt = 0; kt < 16; ++kt)
#pragma unroll
        for (int e = 0; e < 4; ++e) { const float p = __builtin_amdgcn_exp2f(st[kt][e] - mx); st[kt][e] = p; sum += p; }
    sum += __shfl_xor(sum, 16); sum += __shfl_xor(sum, 32);
    const float inv = 1.0f / sum;
    f32x4 o[4];
#pragma unroll
    for (int c = 0; c < 4; ++c) o[c] = (f32x4){0.f, 0.f, 0.f, 0.f};
    const int q4 = (lane & 15) >> 2, p = lane & 3;
#pragma unroll
    for (int kr = 0; kr < 8; ++kr) {
        v4u vreg[4];
#pragma unroll
        for (int ii = 0; ii < 4; ++ii) { const int rw = 8 * ii + (lane >> 3), ch = lane & 7;
            vreg[ii] = *(const v4u*)(QKV + (size_t)(seq0 + (row_start + kr) * 64 + slab_start + rw) * 1536 + 1024 + h * 64 + ch * 8); }
#pragma unroll
        for (int ii = 0; ii < 4; ++ii) { const int rw = 8 * ii + (lane >> 3), ch = lane & 7; *(LAS v4u*)(ldsw + rw * 144 + ch * 16) = vreg[ii]; }
        asm volatile("s_waitcnt lgkmcnt(0)" ::: "memory");
        v4u pa; pa.x = pg8::cvt_pk_bf16(st[2 * kr][0], st[2 * kr][1]); pa.y = pg8::cvt_pk_bf16(st[2 * kr][2], st[2 * kr][3]);
        pa.z = pg8::cvt_pk_bf16(st[2 * kr + 1][0], st[2 * kr + 1][1]); pa.w = pg8::cvt_pk_bf16(st[2 * kr + 1][2], st[2 * kr + 1][3]);
#pragma unroll
        for (int c = 0; c < 4; ++c) {
            const s16x4 lo = __builtin_bit_cast(s16x4, __builtin_amdgcn_ds_read_tr16_b64_v4i16((LAS v4i16_t*)(ldsw + (4 * g + q4) * 144 + (16 * c + 4 * p) * 2)));
            const s16x4 hi = __builtin_bit_cast(s16x4, __builtin_amdgcn_ds_read_tr16_b64_v4i16((LAS v4i16_t*)(ldsw + (16 + 4 * g + q4) * 144 + (16 * c + 4 * p) * 2)));
            const bf16x8 vb = (bf16x8){lo[0], lo[1], lo[2], lo[3], hi[0], hi[1], hi[2], hi[3]};
            o[c] = __builtin_amdgcn_mfma_f32_16x16x32_bf16(__builtin_bit_cast(bf16x8, pa), vb, o[c], 0, 0, 0);
        }
        asm volatile("s_waitcnt lgkmcnt(0)" ::: "memory");
    }
#pragma unroll
    for (int e = 0; e < 4; ++e) { const float li = __shfl(inv, 4 * g + e);
        bf16* op = O + (size_t)(seq0 + r * 64 + 16 * j + 4 * g + e) * 512 + h * 64 + (lane & 15);
#pragma unroll
        for (int c = 0; c < 4; ++c) op[16 * c] = (bf16)f2bf(o[c][e] * li); }
}

namespace mla {
constexpr int SLOT = 20480;
constexpr int WSF = 5 * SLOT;
#define MX3(a, b, c) __builtin_fmaxf(__builtin_fmaxf((a), (b)), (c))
#define SBAR() __builtin_amdgcn_sched_barrier(0)
__device__ __forceinline__ int crow(int r, int hi) { return (r & 3) + 8 * (r >> 2) + 4 * hi; }
__device__ __forceinline__ unsigned cvtpk(float lo, float hi) { return pg8::cvt_pk_bf16(lo, hi); }
__device__ __forceinline__ void glds16(const void* gsrc, unsigned lds_dst) { unsigned keep;
    asm volatile("s_mov_b32 %0, m0\n\ts_mov_b32 m0, %2\n\ts_nop 0\n\tglobal_load_lds_dwordx4 %1, off\n\ts_mov_b32 m0, %0" : "=&s"(keep) : "v"(gsrc), "s"(lds_dst) : "memory"); }
#define WAIT_BAR(N) asm volatile("s_waitcnt vmcnt(" #N ") lgkmcnt(0)\n\ts_barrier" ::: "memory")
constexpr int NSLOT = 5, PF = 4;
template <int THR>
__device__ __forceinline__ void unit(LAS unsigned char* lds, const bf16* Q, const bf16* KV, const bf16* KR, bf16* O, int tok0, int nkt, int h, int qb) {
    int tid_raw = threadIdx.x; asm volatile("" : "+v"(tid_raw));
    const int tid = tid_raw, lane = tid & 63, r32 = lane & 31, hi = lane >> 5; const int wid = __builtin_amdgcn_readfirstlane(tid >> 6);
    LAS float* wsf = (LAS float*)(lds + WSF) + wid * 64;
    const unsigned lds0 = (unsigned)(uintptr_t)lds;
    const bf16* ksrc = KV + (size_t)(tok0 + lane) * 1024 + h * 64 + wid * 8;
    const bf16* vsrc = KV + (size_t)(tok0 + 16 * (wid & 3) + (lane >> 2)) * 1024 + 512 + h * 64 + (wid >> 2) * 32 + (lane & 3) * 8;
    const bf16* rsrc = KR + (size_t)(tok0 + lane) * 32 + (wid & 3) * 8;
    const unsigned kdst = lds0 + wid * 1024, vdst = lds0 + 12288 + wid * 1024, rdst = lds0 + 8192 + (wid & 3) * 1024;
    const bool do_r = wid < 4;
#define DMA_TILE(tt, slot) do { const int t_ = (tt) < nkt ? (tt) : nkt - 1; \
        glds16(ksrc + (size_t)t_ * 65536, (unsigned)__builtin_amdgcn_readfirstlane(kdst + (slot))); \
        glds16(vsrc + (size_t)t_ * 65536, (unsigned)__builtin_amdgcn_readfirstlane(vdst + (slot))); \
        if (do_r) glds16(rsrc + (size_t)t_ * 2048, (unsigned)__builtin_amdgcn_readfirstlane(rdst + (slot))); } while (0)
    const bf16* Qw = Q + (size_t)(tok0 + qb * 256 + wid * 32 + r32) * 768;
    bf16x8 qr[6];
#pragma unroll
    for (int d0 = 0; d0 < 4; ++d0) qr[d0] = *(const bf16x8*)(Qw + h * 64 + d0 * 16 + hi * 8);
    qr[4] = *(const bf16x8*)(Qw + 512 + h * 32 + hi * 8); qr[5] = *(const bf16x8*)(Qw + 512 + h * 32 + 16 + hi * 8);
    DMA_TILE(0, 0); DMA_TILE(1, SLOT); DMA_TILE(2, 2 * SLOT); DMA_TILE(3, 3 * SLOT);
    const int koff = hi * 1024 + r32 * 16;
    const int voff = 12288 + ((lane >> 4) & 1) * 32 + (lane & 3) * 8 + (4 * hi + ((lane & 15) >> 2)) * 64;
    f32x16 o0, o1, negm, pS0, pS1;
#pragma unroll
    for (int r = 0; r < 16; ++r) { o0[r] = 0.f; o1[r] = 0.f; pS0[r] = 0.f; pS1[r] = 0.f; }
    float mhat = 0.f, l = 0.f;
    if (do_r) { WAIT_BAR(6); } else { WAIT_BAR(4); }
#pragma unroll
    for (int d0 = 0; d0 < 6; ++d0) {
        const bf16x8 b0 = *(const LAS bf16x8*)(lds + koff + d0 * 2048), b1 = *(const LAS bf16x8*)(lds + koff + d0 * 2048 + 512);
        pS0 = __builtin_amdgcn_mfma_f32_32x32x16_bf16(b0, qr[d0], pS0, 0, 0, 0);
        pS1 = __builtin_amdgcn_mfma_f32_32x32x16_bf16(b1, qr[d0], pS1, 0, 0, 0);
    }
    {
        float rm = MX3(pS0[0], pS0[1], pS1[0]);
#pragma unroll
        for (int r = 1; r < 16; r += 1) rm = MX3(rm, pS0[r], pS1[r]);
        auto rr = __builtin_amdgcn_permlane32_swap(__float_as_uint(rm), __float_as_uint(rm), false, false); rm = __builtin_fmaxf(__uint_as_float(rr[0]), __uint_as_float(rr[1]));
        mhat = rm;
#pragma unroll
        for (int r = 0; r < 16; ++r) { pS0[r] -= rm; pS1[r] -= rm; negm[r] = -mhat; }
    }
    int s_prev = 4 * SLOT, s_cur = 0, s_n1 = SLOT;
    for (int t = 0; t < nkt; ++t) {
        const bool more1 = (t + 1 < nkt);
        DMA_TILE(t + PF, s_prev);
        bf16x8 kfa[6], kfb[6];
#pragma unroll
        for (int d0 = 0; d0 < 6; ++d0) { kfa[d0] = *(const LAS bf16x8*)(lds + s_n1 + koff + d0 * 2048); kfb[d0] = *(const LAS bf16x8*)(lds + s_n1 + koff + d0 * 2048 + 512); }
        f32x16 pN0 = negm, pN1 = negm;
        unsigned wA[8], wB[8]; float sacc = 0.f;
        SBAR();
#pragma unroll
        for (int i = 0; i < 12; ++i) {
            const int d0 = i >> 1;
            if (i & 1) pN1 = __builtin_amdgcn_mfma_f32_32x32x16_bf16(kfb[d0], qr[d0], pN1, 0, 0, 0);
            else       pN0 = __builtin_amdgcn_mfma_f32_32x32x16_bf16(kfa[d0], qr[d0], pN0, 0, 0, 0);
            SBAR();
#pragma unroll
            for (int r = (i * 16) / 12; r < ((i + 1) * 16) / 12; ++r) {
                pS0[r] = __builtin_amdgcn_exp2f(pS0[r]); pS1[r] = __builtin_amdgcn_exp2f(pS1[r]);
                sacc += pS0[r]; sacc += pS1[r];
                if (r & 1) { wA[r >> 1] = cvtpk(pS0[r - 1], pS0[r]); wB[r >> 1] = cvtpk(pS1[r - 1], pS1[r]); }
            }
            SBAR();
        }
        l += sacc;
        const bf16x8 pw0 = __builtin_bit_cast(bf16x8, (v4u){wA[0], wA[1], wA[2], wA[3]}), pw1 = __builtin_bit_cast(bf16x8, (v4u){wA[4], wA[5], wA[6], wA[7]}),
                     pw2 = __builtin_bit_cast(bf16x8, (v4u){wB[0], wB[1], wB[2], wB[3]}), pw3 = __builtin_bit_cast(bf16x8, (v4u){wB[4], wB[5], wB[6], wB[7]});
#define VFRAG(dst, off_) do { const s16x4 lo_ = __builtin_bit_cast(s16x4, __builtin_amdgcn_ds_read_tr16_b64_v4i16((LAS v4i16_t*)(lds + s_cur + voff + (off_)))); \
        const s16x4 hi_ = __builtin_bit_cast(s16x4, __builtin_amdgcn_ds_read_tr16_b64_v4i16((LAS v4i16_t*)(lds + s_cur + voff + (off_) + 512))); \
        dst = (bf16x8){lo_[0], lo_[1], lo_[2], lo_[3], hi_[0], hi_[1], hi_[2], hi_[3]}; } while (0)
        bf16x8 va0, vb0, va1, vb1, va2, vb2, va3, vb3;
        VFRAG(va0, 0); VFRAG(vb0, 4096); VFRAG(va1, 1024); VFRAG(vb1, 4096 + 1024);
        o0 = __builtin_amdgcn_mfma_f32_32x32x16_bf16(pw0, va0, o0, 0, 0, 0);
        VFRAG(va2, 2048); VFRAG(vb2, 4096 + 2048);
        o1 = __builtin_amdgcn_mfma_f32_32x32x16_bf16(pw0, vb0, o1, 0, 0, 0);
        VFRAG(va3, 3072); VFRAG(vb3, 4096 + 3072);
        o0 = __builtin_amdgcn_mfma_f32_32x32x16_bf16(pw1, va1, o0, 0, 0, 0);
        o1 = __builtin_amdgcn_mfma_f32_32x32x16_bf16(pw1, vb1, o1, 0, 0, 0);
        SBAR();
        float rm = MX3(pN0[0], pN0[1], pN1[0]);
        o0 = __builtin_amdgcn_mfma_f32_32x32x16_bf16(pw2, va2, o0, 0, 0, 0);
        SBAR();
#pragma unroll
        for (int r = 1; r < 6; ++r) rm = MX3(rm, pN0[r], pN1[r]);
        o1 = __builtin_amdgcn_mfma_f32_32x32x16_bf16(pw2, vb2, o1, 0, 0, 0);
        SBAR();
#pragma unroll
        for (int r = 6; r < 11; ++r) rm = MX3(rm, pN0[r], pN1[r]);
        o0 = __builtin_amdgcn_mfma_f32_32x32x16_bf16(pw3, va3, o0, 0, 0, 0);
        SBAR();
#pragma unroll
        for (int r = 11; r < 16; ++r) rm = MX3(rm, pN0[r], pN1[r]);
        o1 = __builtin_amdgcn_mfma_f32_32x32x16_bf16(pw3, vb3, o1, 0, 0, 0);
        SBAR();
#undef VFRAG
        { auto rr = __builtin_amdgcn_permlane32_swap(__float_as_uint(rm), __float_as_uint(rm), false, false); rm = __builtin_fmaxf(__uint_as_float(rr[0]), __uint_as_float(rr[1])); }
        if (more1 && __any(rm > (float)THR)) {
            const float dl = __builtin_fmaxf(rm, 0.f); mhat += dl;
#pragma unroll
            for (int r = 0; r < 16; ++r) { pN0[r] -= dl; pN1[r] -= dl; negm[r] = -mhat; }
            const float f = __builtin_amdgcn_exp2f(-dl); l *= f;
            if (hi == 0) wsf[r32] = f;
            asm volatile("s_waitcnt lgkmcnt(0)" ::: "memory");
#pragma unroll
            for (int r = 0; r < 16; ++r) { const float fr = wsf[crow(r, hi)]; o0[r] *= fr; o1[r] *= fr; }
            asm volatile("s_waitcnt lgkmcnt(0)" ::: "memory");
        }
        if (do_r) { WAIT_BAR(6); } else { WAIT_BAR(4); }
        pS0 = pN0; pS1 = pN1;
        s_prev = s_cur; s_cur = s_n1; s_n1 = (s_n1 == (NSLOT - 1) * SLOT) ? 0 : s_n1 + SLOT;
    }
    { auto rr = __builtin_amdgcn_permlane32_swap(__float_as_uint(l), __float_as_uint(l), false, false); l = __uint_as_float(rr[0]) + __uint_as_float(rr[1]); }
    if (hi == 0) wsf[32 + r32] = l;
    asm volatile("s_waitcnt lgkmcnt(0)" ::: "memory");
    bf16* Ow = O + (size_t)(tok0 + qb * 256 + wid * 32) * 512 + h * 64 + r32;
#pragma unroll
    for (int r = 0; r < 16; ++r) { const int row = crow(r, hi); const float li = 1.0f / wsf[32 + row];
        Ow[(size_t)row * 512] = (bf16)f2bf(o0[r] * li); Ow[(size_t)row * 512 + 32] = (bf16)f2bf(o1[r] * li); }
    WAIT_BAR(0);
#undef DMA_TILE
}
__device__ __forceinline__ void decode(int idx, int& tok0, int& nkt, int& h, int& qb) {
    if (idx < 1024) { const int pair = idx >> 6; qb = idx & 63; h = pair & 7; tok0 = (pair >> 3) * SEQ_P; nkt = SEQ_P / 64; }
    else { const int i2 = idx - 1024, pair = i2 >> 4; qb = i2 & 15; h = pair & 7; tok0 = MPROMPT + (pair >> 3) * SEQ_S; nkt = SEQ_S / 64; }
}
}

#ifndef SKIP_MLA
#define MLA_UNIT_CALL mla::unit<8>(lds, QB, KVB, KRB, MLAO, tok0, nkt, h, qb)
#else
#define MLA_UNIT_CALL (void)0
#endif
struct Args { const float* in[22]; float* out; unsigned char* ws; float inv_freq[16]; };
enum { I_XP = 0, I_XS, I_F1IN, I_F1OUT, I_LN1G, I_LN1B, I_WIN, I_BGATE, I_RPB, I_QNG, I_KVNG, I_WUQ, I_WUKV, I_WNAO, I_WMLAO, I_WOUT, I_LN2G, I_LN2B, I_F2IN, I_F2OUT, I_LN3G, I_LN3B };

#ifndef NA_SCALE
#define NA_SCALE 1.0f
#endif
#ifndef PH_LAST
#define PH_LAST 99
#endif

__global__ void __launch_bounds__(NWAVES * 64, 2) fwd_megakernel(Args a) {
    extern __shared__ __attribute__((aligned(16))) unsigned char lds_raw[];
    LAS unsigned char* lds = (LAS unsigned char*)lds_raw;
    cg::grid_group grid = cg::this_grid();
    const int G = gridDim.x, bx = blockIdx.x, NGW = G * NWAVES;
#define FRESH_IDS() int tid = threadIdx.x; asm volatile("" : "+v"(tid)); const int lane = tid & 63, wave = __builtin_amdgcn_readfirstlane(tid >> 6), gw = bx * NWAVES + wave; (void)lane; (void)gw
    unsigned char* ws = a.ws;
    bf16 *W1in = (bf16*)(ws + WS_W1IN), *W1out = (bf16*)(ws + WS_W1OUT), *W2in = (bf16*)(ws + WS_W2IN), *W2out = (bf16*)(ws + WS_W2OUT), *Win = (bf16*)(ws + WS_WIN), *Wg = (bf16*)(ws + WS_WG),
         *Wuq = (bf16*)(ws + WS_WUQ), *Wukv = (bf16*)(ws + WS_WUKV), *Wnao = (bf16*)(ws + WS_WNAO), *Wmlao = (bf16*)(ws + WS_WMLAO), *Wout = (bf16*)(ws + WS_WOUT);
    float* cosT = (float*)(ws + WS_ROPE); float* sinT = cosT + 16384 * 16;
    bf16* XB = (bf16*)(ws + WS_XB);
    unsigned char* R = ws + WS_R;
    bf16 *ACT = (bf16*)(R + R_ACT), *NAQKV = (bf16*)(R + R_NAQKV), *CB = (bf16*)(R + R_C), *QB = (bf16*)(R + R_Q), *MLAO = (bf16*)(R + R_MLAO), *NAO = (bf16*)(R + R_NAO),
         *KVB = (bf16*)(R + R_KV), *KRB = (bf16*)(R + R_KR), *GB = (bf16*)(R + R_G), *TB = (bf16*)(R + R_T);
    float* out = a.out;
#define GRID_SYNC() do { asm volatile("s_waitcnt vmcnt(0) lgkmcnt(0)" ::: "memory"); grid.sync(); asm volatile("" ::: "memory"); } while (0)

#ifndef REP_P0
#define REP_P0 1
#endif
    for (int rep0_ = 0; rep0_ < REP_P0; ++rep0_) {
        FRESH_IDS();
        LAS float* scr = (LAS float*)(lds + wave * 16384);
        constexpr int I_FIN = 16 * 176, I_FOUT = 44 * 32, I_MIN = 16 * 133, I_UQ = 6 * 24, I_UKV = 4 * 32, I_O512 = 8 * 32, I_O1024 = 16 * 32;
        constexpr int NITEMS = 2 * I_FIN + 2 * I_FOUT + I_MIN + I_UQ + I_UKV + 2 * I_O512 + I_O1024;
        for (int it = gw; it < NITEMS; it += NGW) {
            int r = it;
            if (r < 2 * I_FIN) { const int which = r / I_FIN; r -= which * I_FIN; const int kb = r / 176, nb = r % 176; const int c0 = 32 * nb, s = c0 / DFF, j0 = c0 % DFF;
                p0_transpose_item(a.in[which ? I_F2IN : I_F1IN], DM, 2 * DFF, which ? W2in : W1in, 256 * (j0 / 128) + 128 * s + (j0 % 128), scr, kb, nb, lane); continue; }
            r -= 2 * I_FIN;
            if (r < 2 * I_FOUT) { const int which = r / I_FOUT; r -= which * I_FOUT; const int kb = r / 32, nb = r % 32;
                p0_transpose_item(a.in[which ? I_F2OUT : I_F1OUT], DFF, DM, which ? W2out : W1out, 32 * nb, scr, kb, nb, lane); continue; }
            r -= 2 * I_FOUT;
            if (r < I_MIN) { const int kb = r / 133, nb = r % 133; const int c0 = 32 * nb; bf16* dst = Win; int drow;
                if (c0 < 1536) drow = c0; else if (c0 < 1920) drow = 1536 + 256 + (c0 - 1536); else if (c0 < 2176) drow = 1536 + (c0 - 1920); else if (c0 < 2208) drow = 1536 + 640; else { dst = Wg; drow = c0 - 2208; }
                p0_transpose_item(a.in[I_WIN], DM, 4256, dst, drow, scr, kb, nb, lane); continue; }
            r -= I_MIN;
            if (r < I_UQ) { const int kb = r / 24, nb = r % 24; const int hh = nb / 3, part = nb % 3; const int drow = part < 2 ? hh * 64 + 32 * part : 512 + hh * 32;
                p0_transpose_item(a.in[I_WUQ], 384, 768, Wuq, drow, scr, kb, nb, lane); continue; }
            r -= I_UQ;
            if (r < I_UKV) { const int kb = r / 32, nb = r % 32; const int hh = nb / 4, part = nb % 4; const int drow = part < 2 ? hh * 64 + 32 * part : 512 + hh * 64 + 32 * (part - 2);
                p0_transpose_item(a.in[I_WUKV], 256, 1024, Wukv, drow, scr, kb, nb, lane); continue; }
            r -= I_UKV;
            if (r < 2 * I_O512) { const int which = r / I_O512; r -= which * I_O512; const int kb = r / 32, nb = r % 32;
                p0_transpose_item(a.in[which ? I_WMLAO : I_WNAO], 512, DM, which ? Wmlao : Wnao, 32 * nb, scr, kb, nb, lane); continue; }
            r -= 2 * I_O512;
            { const int kb = r / 32, nb = r % 32; p0_transpose_item(a.in[I_WOUT], DM, DM, Wout, 32 * nb, scr, kb, nb, lane); }
        }
        const int gt = bx * (NWAVES * 64) + tid, NGT = G * NWAVES * 64;
        for (int i = gt; i < 96 * 1024 * 2 / 16; i += NGT) ((v4u*)(Win + (size_t)2208 * 1024))[i] = (v4u){0u, 0u, 0u, 0u};
        for (int i = gt; i < 16384 * 16; i += NGT) { const int pos = i >> 4, k = i & 15; const float ang = (float)pos * a.inv_freq[k];
            const double rev = (double)ang * 0.15915494309189535; const float fr = (float)(rev - floor(rev));
            cosT[i] = __builtin_amdgcn_cosf(fr); sinT[i] = __builtin_amdgcn_sinf(fr); }
        rows_phase<false, false, true>(a.in[I_XP], nullptr, XB, nullptr, nullptr, 0, MPROMPT, gw, NGW, lane);
        rows_phase<false, false, true>(a.in[I_XS], nullptr, XB, nullptr, nullptr, MPROMPT, MTOK, gw, NGW, lane);
    }
    GRID_SYNC();
#define FFN_BLOCK(WIN_, WOUT_, BASE0_, BASE1_, SPLIT_, LNG_, LNB_, WBF_) do { \
        { pg8::Gemm g{XB, WIN_, MTOK, 2 * DFF, DM, DM}; pg8::StaticOrder S; S.init(MTOK, 2 * DFF, G, bx); pg8::EpiSwiGLU E{ACT, DFF}; \
          pg8::gemm_phase<pg8::EpiSwiGLU, pg8::StaticOrder, true, true>(lds, g, S, E); } \
        GRID_SYNC(); \
        { pg8::Gemm g{ACT, WOUT_, MTOK, DM, DFF, DFF}; pg8::StaticOrder S; S.init(MTOK, DM, G, bx); pg8::EpiResid E{BASE0_, BASE1_, SPLIT_, out, ALPHA, 0.5f}; \
          pg8::gemm_phase<pg8::EpiResid, pg8::StaticOrder, true, true>(lds, g, S, E); } \
        GRID_SYNC(); \
        { FRESH_IDS(); rows_phase<true, true, WBF_>(out, out, XB, LNG_, LNB_, 0, MTOK, gw, NGW, lane); } \
    } while (0)

#ifdef REP_SYNC
    for (int i_ = 0; i_ < REP_SYNC; ++i_) { GRID_SYNC(); }
#endif
#ifdef REP_P1
    { pg8::Gemm g{XB, W1in, MTOK, 2 * DFF, DM, DM}; pg8::StaticOrder S; S.init(MTOK, 2 * DFF, G, bx); pg8::EpiSwiGLU E{ACT, DFF};
      pg8::gemm_phase<pg8::EpiSwiGLU, pg8::StaticOrder, true, true>(lds, g, S, E); }
    GRID_SYNC();
#endif
    FFN_BLOCK(W1in, W1out, a.in[I_XP], a.in[I_XS] - (size_t)MPROMPT * DM, MPROMPT / 256, a.in[I_LN1G], a.in[I_LN1B], true);
    GRID_SYNC();
    { pg8::Gemm g{XB, Win, MTOK, 2304, DM, DM}; pg8::StaticOrder S; S.init(MTOK, 2304, G, bx); pg8::EpiBf16<0> E{NAQKV, 1536, 6, CB, 768, nullptr};
      pg8::gemm_phase<pg8::EpiBf16<0>, pg8::StaticOrder, true, true>(lds, g, S, E); }
    GRID_SYNC();
    { FRESH_IDS(); prep_phase(CB, KRB + 0, a.in[I_QNG], a.in[I_KVNG], cosT, sinT, gw, NGW, lane); }
#ifndef REP_NA
#define REP_NA 1
#endif
    for (int rep_ = 0; rep_ < REP_NA; ++rep_) { FRESH_IDS();
    for (int ub = bx; ub < MTOK / 16; ub += G) {
        const int tok = 16 * ub; int seq0, rows;
        if (tok < MPROMPT) { seq0 = (tok / SEQ_P) * SEQ_P; rows = SEQ_P / 64; } else { seq0 = MPROMPT + ((tok - MPROMPT) / SEQ_S) * SEQ_S; rows = SEQ_S / 64; }
        const int pos = tok - seq0;
#ifndef SKIP_NA
        na_task(lds + wave * 4608, NAQKV, NAO, a.in[I_RPB], seq0, rows, pos >> 6, (pos & 63) >> 4, wave, lane);
#endif
    } }
    GRID_SYNC();
    { pg8::Gemm g{CB + 256, Wuq, MTOK, 768, 384, 768}; pg8::StaticOrder S; S.init(MTOK, 768, G, bx); pg8::EpiQRope E{QB, cosT, sinT, QSCALE};
      pg8::gemm_phase<pg8::EpiQRope, pg8::StaticOrder, true, true>(lds, g, S, E); }
    { pg8::Gemm g{CB, Wukv, MTOK, 1024, 256, 768}; pg8::StaticOrder S; S.init(MTOK, 1024, G, bx); pg8::EpiBf16<0> E{KVB, 1024, 99, nullptr, 0, nullptr};
      pg8::gemm_phase<pg8::EpiBf16<0>, pg8::StaticOrder, true, true>(lds, g, S, E); }
    GRID_SYNC();
#ifndef REP_MLA
#define REP_MLA 1
#endif
    for (int rep_ = 0; rep_ < REP_MLA; ++rep_) {
        if (G == 256) {
            const int xcd = bx & 7, l = bx >> 3;
            for (int i = 0; i < 12; ++i) {
                int idx;
                if (i < 4) { const int pair = xcd + 8 * (i >> 1), qb = 2 * l + (i & 1); idx = pair * 64 + qb; }
                else { const int u = (i - 4) * 32 + l; const int pair = xcd + 8 * (u >> 4); idx = 1024 + pair * 16 + (u & 15); }
                int tok0, nkt, h, qb; mla::decode(idx, tok0, nkt, h, qb);
                MLA_UNIT_CALL;
            }
        } else {
            for (int idx = bx; idx < 3072; idx += G) { int tok0, nkt, h, qb; mla::decode(idx, tok0, nkt, h, qb); MLA_UNIT_CALL; }
        }
    }
    GRID_SYNC();
#ifdef REP_P8
    { pg8::Gemm g{XB, Wg, MTOK, 2048, DM, DM}; pg8::StaticOrder S; S.init(MTOK, 2048, G, bx); pg8::EpiBf16<1> E{GB, 2048, 99, nullptr, 0, a.in[I_BGATE]};
      pg8::gemm_phase<pg8::EpiBf16<1>, pg8::StaticOrder, true, true>(lds, g, S, E); }
    GRID_SYNC();
#endif
    { pg8::Gemm g{XB, Wg, MTOK, 2048, DM, DM}; pg8::StaticOrder S; S.init(MTOK, 2048, G, bx); pg8::EpiBf16<1> E{GB, 2048, 99, nullptr, 0, a.in[I_BGATE]};
      pg8::gemm_phase<pg8::EpiBf16<1>, pg8::StaticOrder, true, true>(lds, g, S, E); }
    GRID_SYNC();
    { pg8::Gemm g{NAO, Wnao, MTOK, DM, 512, 512}; pg8::StaticOrder S; S.init(MTOK, DM, G, bx); pg8::EpiGateMul<0> E{GB, 2048, TB, NA_SCALE};
      pg8::gemm_phase<pg8::EpiGateMul<0>, pg8::StaticOrder, true, true>(lds, g, S, E); }
    __syncthreads();
#ifndef NO_MLA_BRANCH
    { pg8::Gemm g{MLAO, Wmlao, MTOK, DM, 512, 512}; pg8::StaticOrder S; S.init(MTOK, DM, G, bx); pg8::EpiGateMul<1> E{GB + 1024, 2048, TB, 1.0f};
      pg8::gemm_phase<pg8::EpiGateMul<1>, pg8::StaticOrder, true, true>(lds, g, S, E); }
#endif
    GRID_SYNC();
    { pg8::Gemm g{TB, Wout, MTOK, DM, DM, DM}; pg8::StaticOrder S; S.init(MTOK, DM, G, bx); pg8::EpiResid E{out, out, 0, out, ALPHA, 1.0f};
      pg8::gemm_phase<pg8::EpiResid, pg8::StaticOrder, true, true>(lds, g, S, E); }
    GRID_SYNC();
    { FRESH_IDS(); rows_phase<true, true, true>(out, out, XB, a.in[I_LN2G], a.in[I_LN2B], 0, MTOK, gw, NGW, lane); }
    GRID_SYNC();
    FFN_BLOCK(W2in, W2out, out, out, 0, a.in[I_LN3G], a.in[I_LN3B], false);
}

extern "C" void kernel_launch(void* const* d_in, const int* in_sizes, int n_in, void* d_out, int out_size, void* d_ws, size_t ws_size, hipStream_t stream) {
    static int grid = 0;
    if (grid == 0) {
        if (n_in != 22 || out_size != MTOK * DM || ws_size < WS_END) { fprintf(stderr, "kernel_launch: unexpected shapes (n_in %d, out %d, ws %zu)\n", n_in, out_size, ws_size); grid = -1; return; }
        int dev = 0, cus = 0, per_cu = 0;
        hipGetDevice(&dev); hipDeviceGetAttribute(&cus, hipDeviceAttributeMultiprocessorCount, dev);
        hipFuncSetAttribute((const void*)fwd_megakernel, hipFuncAttributeMaxDynamicSharedMemorySize, LDS_BYTES);
        hipOccupancyMaxActiveBlocksPerMultiprocessor(&per_cu, (const void*)fwd_megakernel, NWAVES * 64, LDS_BYTES);
        if (per_cu < 1) per_cu = 1;
        (void)hipGetLastError();
        grid = cus * per_cu;
    }
    if (grid < 0) return;
    Args a{};
    for (int i = 0; i < 22; ++i) a.in[i] = (const float*)d_in[i];
    a.out = (float*)d_out; a.ws = (unsigned char*)d_ws;
    for (int i = 0; i < 16; ++i) a.inv_freq[i] = 1.0f / powf(10000.0f, (float)(2 * i) / 32.0f);
    void* args[] = {&a};
    hipError_t e = hipLaunchCooperativeKernel((const void*)fwd_megakernel, dim3(grid), dim3(NWAVES * 64), args, LDS_BYTES, stream);
    if (e != hipSuccess) fprintf(stderr, "cooperative launch failed: %s (grid %d)\n", hipGetErrorString(e), grid);
}
```

```cpp
#include <hip/hip_runtime.h>
#include <hip/hip_cooperative_groups.h>
#include <cstdio>
#include <cstdint>
#include <cmath>
namespace cg = cooperative_groups;
namespace pg8 {
#define PG8_LAS __attribute__((address_space(3)))
typedef unsigned short bf16_t;
typedef short bf16x8 __attribute__((ext_vector_type(8)));
typedef float f32x4 __attribute__((ext_vector_type(4)));
typedef unsigned u32x4 __attribute__((ext_vector_type(4)));
constexpr int BM = 256, BK = 64, HALF = 128, HTB = HALF * BK * 2  , STAGE_BYTES = 8 * HTB, NXCD = 8, WGM = 8;

__host__ __device__ __forceinline__ int lds_byte(int r, int c) { const int st = (r >> 4) * 2 + (c >> 5), rr = r & 15, cc = c & 31, ob = rr * 64 + cc * 2; return st * 1024 + (ob ^ (((ob >> 9) & 1) << 5)); }
__host__ __device__ __forceinline__ void stage_rc(int b, int& R, int& C) { const int st = b / 1024, sb = b % 1024, swz = sb ^ (((sb >> 9) & 1) << 5); R = (st >> 1) * 16 + swz / 64; C = (st & 1) * 32 + (swz % 64) / 2; }
__host__ __device__ __forceinline__ int perm32(int rho) { const int n = rho >> 4, i = rho & 15; return 8 * (i >> 2) + 4 * n + (i & 3); }

struct Unit { int pm, pn; };
struct Gemm { const bf16_t* A; const bf16_t* Bt; int M, N, K, lda; };

struct StaticOrder {
    int nM, nN, nwg, G, c;
    __host__ __device__ void init(int M, int N, int G_, int c_) { nM = M / BM; nN = N / BM; nwg = nM * nN; G = G_; c = c_; }
    __host__ __device__ bool next(int i, Unit& u) const {
        const long L = (long)i * G + c; if (L >= nwg) return false;
        int wgid = (int)L; { const int q = nwg / NXCD, r = nwg % NXCD, xcd = wgid % NXCD, off = wgid / NXCD; wgid = (xcd < r ? xcd * (q + 1) : r * (q + 1) + (xcd - r) * q) + off; }
        const int nig = WGM * nN, gid = wgid / nig, fm = gid * WGM, gsz = (nM - fm) < WGM ? (nM - fm) : WGM;
        u.pm = fm + ((wgid % nig) % gsz); u.pn = (wgid % nig) / gsz; return true;
    }
    __device__ __forceinline__ void a_ready(const Unit&) const {}
    __device__ __forceinline__ void done(const Unit&) const {}
};


typedef unsigned u32x2 __attribute__((ext_vector_type(2)));
typedef float f32x2_t __attribute__((ext_vector_type(2))); typedef __bf16 bf16x2_t __attribute__((ext_vector_type(2)));
__device__ __forceinline__ unsigned cvt_pk_bf16(float lo, float hi) { f32x2_t v = {lo, hi}; bf16x2_t b = __builtin_convertvector(v, bf16x2_t); return __builtin_bit_cast(unsigned, b); }
__device__ __forceinline__ float bf_lo(unsigned w) { return __uint_as_float(w << 16); }
__device__ __forceinline__ float bf_hi(unsigned w) { return __uint_as_float(w & 0xffff0000u); }
__device__ __forceinline__ float fsigmoid(float x) { return __builtin_amdgcn_rcpf(1.0f + __builtin_amdgcn_exp2f(-1.4426950408889634f * x)); }

struct EpiSwiGLU {
    static constexpr bool PERM = true, AFTER_DRAIN = false;
    bf16_t* O; int ldc;
    __device__ __forceinline__ void operator()(const f32x4 (&acc)[2][2][4][2], const Unit& u, int wr, int wc, int fr, int fq) const {
        const int row0 = u.pm * BM + wr * 64 + fr, col0 = u.pn * HALF + wc * 32 + 8 * fq;
#pragma unroll
        for (int ai = 0; ai < 2; ++ai)
#pragma unroll
            for (int m = 0; m < 4; ++m) { bf16_t* rowp = O + (size_t)(row0 + ai * HALF + m * 16) * ldc + col0;
                f32x4 h0, h1;
#pragma unroll
                for (int e = 0; e < 4; ++e) { const float a0 = acc[ai][0][m][0][e], a1 = acc[ai][0][m][1][e];
                    h0[e] = a0 * fsigmoid(a0) * acc[ai][1][m][0][e]; h1[e] = a1 * fsigmoid(a1) * acc[ai][1][m][1][e]; }
                u32x4 w; w.x = cvt_pk_bf16(h0[0], h0[1]); w.y = cvt_pk_bf16(h0[2], h0[3]); w.z = cvt_pk_bf16(h1[0], h1[1]); w.w = cvt_pk_bf16(h1[2], h1[3]);
                *(u32x4*)rowp = w; }
    }
};
struct EpiResid {
    static constexpr bool PERM = false, AFTER_DRAIN = false;
    const float* base0; const float* base1; int split_pm; float* out; float alpha, s;
    __device__ __forceinline__ void operator()(const f32x4 (&acc)[2][2][4][2], const Unit& u, int wr, int wc, int fr, int fq) const {
        const int row0 = u.pm * BM + wr * 64 + fr, col0 = u.pn * BM + wc * 32 + 4 * fq;
        const float* base = (u.pm < split_pm) ? base0 : base1;
#pragma unroll
        for (int ai = 0; ai < 2; ++ai)
#pragma unroll
            for (int m = 0; m < 4; ++m) { const size_t off = (size_t)(row0 + ai * HALF + m * 16) * 1024 + col0;
#pragma unroll
                for (int bj = 0; bj < 2; ++bj)
#pragma unroll
                    for (int n = 0; n < 2; ++n) { const f32x4 b = *(const f32x4*)(base + off + bj * HALF + n * 16);
                        const f32x4 o = b * alpha + acc[ai][bj][m][n] * s; *(f32x4*)(out + off + bj * HALF + n * 16) = o; }
                asm volatile("" ::: "memory"); }
    }
};
template <int ACT> struct EpiBf16 {
    static constexpr bool PERM = true, AFTER_DRAIN = false;
    bf16_t* O0; int ld0; int nsplit; bf16_t* O1; int ld1; const float* bias;
    __device__ __forceinline__ void operator()(const f32x4 (&acc)[2][2][4][2], const Unit& u, int wr, int wc, int fr, int fq) const {
        bf16_t* base; int ld, colt;
        if (u.pn < nsplit) { base = O0; ld = ld0; colt = u.pn * BM; } else { base = O1; ld = ld1; colt = (u.pn - nsplit) * BM; }
        const int row0 = u.pm * BM + wr * 64 + fr, col0 = colt + wc * 32 + 8 * fq, bcol0 = u.pn * BM + wc * 32 + 8 * fq;
        f32x4 bv[2][2];
#pragma unroll
        for (int bj = 0; bj < 2; ++bj)
#pragma unroll
            for (int n = 0; n < 2; ++n) bv[bj][n] = ACT ? *(const f32x4*)(bias + bcol0 + bj * HALF + 4 * n) : (f32x4){0.f, 0.f, 0.f, 0.f};
#pragma unroll
        for (int ai = 0; ai < 2; ++ai)
#pragma unroll
            for (int m = 0; m < 4; ++m) { bf16_t* rowp = base + (size_t)(row0 + ai * HALF + m * 16) * ld + col0;
#pragma unroll
                for (int bj = 0; bj < 2; ++bj) { f32x4 v0 = acc[ai][bj][m][0], v1 = acc[ai][bj][m][1];
                    if (ACT) { v0 = v0 + bv[bj][0]; v1 = v1 + bv[bj][1];
#pragma unroll
                        for (int e = 0; e < 4; ++e) { v0[e] = fsigmoid(v0[e]); v1[e] = fsigmoid(v1[e]); } }
                    u32x4 w; w.x = cvt_pk_bf16(v0[0], v0[1]); w.y = cvt_pk_bf16(v0[2], v0[3]); w.z = cvt_pk_bf16(v1[0], v1[1]); w.w = cvt_pk_bf16(v1[2], v1[3]);
                    *(u32x4*)(rowp + bj * HALF) = w; } }
    }
};
template <int ACCUM> struct EpiGateMul {
    static constexpr bool PERM = true, AFTER_DRAIN = false;
    const bf16_t* G; int ldg; bf16_t* T; float sc;
    __device__ __forceinline__ void operator()(const f32x4 (&acc)[2][2][4][2], const Unit& u, int wr, int wc, int fr, int fq) const {
        const int row0 = u.pm * BM + wr * 64 + fr, col0 = u.pn * BM + wc * 32 + 8 * fq;
#pragma unroll
        for (int ai = 0; ai < 2; ++ai)
#pragma unroll
            for (int m = 0; m < 4; ++m) { const size_t row = (size_t)(row0 + ai * HALF + m * 16);
#pragma unroll
                for (int bj = 0; bj < 2; ++bj) { const u32x4 g = *(const u32x4*)(G + row * ldg + col0 + bj * HALF);
                    u32x4 t = (u32x4){0u, 0u, 0u, 0u}; if (ACCUM) t = *(const u32x4*)(T + row * 1024 + col0 + bj * HALF);
                    const f32x4 v0 = acc[ai][bj][m][0] * sc, v1 = acc[ai][bj][m][1] * sc;
                    u32x4 w;
                    w.x = cvt_pk_bf16(bf_lo(t.x) + bf_lo(g.x) * v0[0], bf_hi(t.x) + bf_hi(g.x) * v0[1]);
                    w.y = cvt_pk_bf16(bf_lo(t.y) + bf_lo(g.y) * v0[2], bf_hi(t.y) + bf_hi(g.y) * v0[3]);
                    w.z = cvt_pk_bf16(bf_lo(t.z) + bf_lo(g.z) * v1[0], bf_hi(t.z) + bf_hi(g.z) * v1[1]);
                    w.w = cvt_pk_bf16(bf_lo(t.w) + bf_lo(g.w) * v1[2], bf_hi(t.w) + bf_hi(g.w) * v1[3]);
                    *(u32x4*)(T + row * 1024 + col0 + bj * HALF) = w; asm volatile("" ::: "memory"); } }
    }
};
struct EpiQRope {
    static constexpr bool PERM = false, AFTER_DRAIN = false;
    bf16_t* Q; const float* cosT; const float* sinT; float qscale;
    __device__ __forceinline__ void operator()(const f32x4 (&acc)[2][2][4][2], const Unit& u, int wr, int wc, int fr, int fq) const {
        const int row0 = u.pm * BM + wr * 64 + fr;
        if (u.pn < 2) {
            const int col0 = u.pn * BM + wc * 32 + 4 * fq;
#pragma unroll
            for (int ai = 0; ai < 2; ++ai)
#pragma unroll
                for (int m = 0; m < 4; ++m) { bf16_t* rowp = Q + (size_t)(row0 + ai * HALF + m * 16) * 768 + col0;
#pragma unroll
                    for (int bj = 0; bj < 2; ++bj)
#pragma unroll
                        for (int n = 0; n < 2; ++n) { const f32x4 v = acc[ai][bj][m][n] * qscale; u32x2 w; w.x = cvt_pk_bf16(v[0], v[1]); w.y = cvt_pk_bf16(v[2], v[3]);
                            *(u32x2*)(rowp + bj * HALF + n * 16) = w; } }
        } else {
#pragma unroll
            for (int ai = 0; ai < 2; ++ai)
#pragma unroll
                for (int m = 0; m < 4; ++m) { const int row = row0 + ai * HALF + m * 16; const int pos = row < 32768 ? (row & 16383) : (row & 4095);
                    const f32x4 cs = *(const f32x4*)(cosT + pos * 16 + 4 * fq), sn = *(const f32x4*)(sinT + pos * 16 + 4 * fq);
                    bf16_t* rowp = Q + (size_t)row * 768 + 512 + 4 * fq;
#pragma unroll
                    for (int bj = 0; bj < 2; ++bj) { const f32x4 x1 = acc[ai][bj][m][0], x2 = acc[ai][bj][m][1];
                        const f32x4 o1 = (x1 * cs - x2 * sn) * qscale, o2 = (x1 * sn + x2 * cs) * qscale; const int head = 4 * bj + wc;
                        u32x2 w1, w2; w1.x = cvt_pk_bf16(o1[0], o1[1]); w1.y = cvt_pk_bf16(o1[2], o1[3]); w2.x = cvt_pk_bf16(o2[0], o2[1]); w2.y = cvt_pk_bf16(o2[2], o2[3]);
                        *(u32x2*)(rowp + head * 32) = w1; *(u32x2*)(rowp + head * 32 + 16) = w2; }
                    asm volatile("" ::: "memory"); }
        }
    }
};

template <class Epi, class Sched, bool ALIGN_EPI = false, bool SP2 = false>
__device__ __forceinline__ void gemm_phase(PG8_LAS unsigned char* lds, const Gemm g, const Sched& S, const Epi& E) {
    int tid_raw = threadIdx.x; asm volatile("" : "+v"(tid_raw));
    const int tid = tid_raw, wid = __builtin_amdgcn_readfirstlane(tid >> 6), lane = tid & 63, wr = wid >> 2, wc = wid & 3, fr = lane & 15, fq = lane >> 4;
    int K_raw = g.K; asm volatile("" : "+s"(K_raw));
    const int K = K_raw, nt = K / BK;
    unsigned voffA[2], voffB[2];
#pragma unroll
    for (int i = 0; i < 2; ++i) { int R, C; stage_rc(tid * 16 + i * 8192, R, C); const int Rb = Epi::PERM ? ((R & ~31) + perm32(R & 31)) : R;
        voffA[i] = (unsigned)(R * g.lda + C) * 2u; voffB[i] = (unsigned)(Rb * K + C) * 2u; }
    const size_t kstep = (size_t)(BK * 2);
    const size_t hstepB = (size_t)HALF * K * 2, hstepA = (size_t)HALF * g.lda * 2;
    const size_t tstepA = 2 * hstepA, tstepB = 2 * hstepB;
    const unsigned ldsw = (unsigned)wid * 1024u;
    const int aoff = lds_byte(wr * 64 + fr, fq * 8), boff = lds_byte(wc * 32 + fr, fq * 8);
#define PG8_SA(b, h) (((b) * 2 + (h)) * HTB)
#define PG8_SB(b, h) ((4 + (b) * 2 + (h)) * HTB)
#define PG8_STAGE(bufoff, gbase, voff) do { _Pragma("unroll") for (int _i = 0; _i < 2; ++_i) \
        __builtin_amdgcn_global_load_lds((const unsigned*)((const char*)(gbase) + (voff)[_i]), (PG8_LAS unsigned*)(lds + (bufoff) + ldsw + _i * 8192), 16, 0, 0); } while (0)
#define PG8_LDA(dst, b, h) do { _Pragma("unroll") for (int m = 0; m < 4; ++m) _Pragma("unroll") for (int k = 0; k < 2; ++k) dst[m][k] = *(const PG8_LAS bf16x8*)(lds + PG8_SA(b, h) + aoff + m * 2048 + k * 1024); } while (0)
#define PG8_LDB(dst, b, h) do { _Pragma("unroll") for (int n = 0; n < 2; ++n) _Pragma("unroll") for (int k = 0; k < 2; ++k) dst[n][k] = *(const PG8_LAS bf16x8*)(lds + PG8_SB(b, h) + boff + n * 2048 + k * 1024); } while (0)
#define PG8_MMA(ai, bj, At, Bt) do { __builtin_amdgcn_s_setprio(1); _Pragma("unroll") for (int m = 0; m < 4; ++m) _Pragma("unroll") for (int n = 0; n < 2; ++n) _Pragma("unroll") for (int k = 0; k < 2; ++k) \
        acc[ai][bj][m][n] = __builtin_amdgcn_mfma_f32_16x16x32_bf16(Bt[n][k], At[m][k], acc[ai][bj][m][n], 0, 0, 0); __builtin_amdgcn_s_setprio(0); } while (0)
#define PG8_WAIT_V(n) asm volatile("s_waitcnt vmcnt(" #n ")" ::: "memory")
#define PG8_WAIT_L(n) asm volatile("s_waitcnt lgkmcnt(" #n ")" ::: "memory")
#define PG8_BAR __builtin_amdgcn_s_barrier()
#define PG8_SCHED __builtin_amdgcn_sched_barrier(0)
    Unit cur, nxt; int ui = 0;
    if (!S.next(0, cur)) return;
    f32x4 acc[2][2][4][2];
#pragma unroll
    for (int a = 0; a < 2; ++a)
#pragma unroll
        for (int b = 0; b < 2; ++b)
#pragma unroll
            for (int m = 0; m < 4; ++m)
#pragma unroll
                for (int n = 0; n < 2; ++n) acc[a][b][m][n] = (f32x4){0.f, 0.f, 0.f, 0.f};
    bf16x8 At[4][2], B0[2][2], B1[2][2];
    const char* cA = (const char*)g.A + (size_t)cur.pm * tstepA; const char* cB = (const char*)g.Bt + (size_t)cur.pn * tstepB;
    S.a_ready(cur);
    if constexpr (SP2) {
        PG8_STAGE(PG8_SB(0, 0), cB, voffB); PG8_STAGE(PG8_SB(0, 1), cB + hstepB, voffB); PG8_STAGE(PG8_SA(0, 0), cA, voffA); PG8_STAGE(PG8_SA(0, 1), cA + hstepA, voffA);
        if (wr == 1) PG8_BAR;
        PG8_WAIT_V(2); PG8_BAR;
        PG8_STAGE(PG8_SB(1, 0), cB + kstep, voffB); PG8_STAGE(PG8_SA(1, 0), cA + kstep, voffA); PG8_STAGE(PG8_SB(1, 1), cB + hstepB + kstep, voffB);
        PG8_WAIT_V(6); PG8_BAR;
    } else {
        PG8_STAGE(PG8_SB(0, 0), cB, voffB); PG8_STAGE(PG8_SA(0, 0), cA, voffA); PG8_STAGE(PG8_SB(0, 1), cB + hstepB, voffB); PG8_STAGE(PG8_SA(0, 1), cA + hstepA, voffA);
        if (wr == 1) PG8_BAR;
        PG8_WAIT_V(4); PG8_BAR;
        PG8_STAGE(PG8_SB(1, 0), cB + kstep, voffB); PG8_STAGE(PG8_SA(1, 0), cA + kstep, voffA); PG8_STAGE(PG8_SB(1, 1), cB + hstepB + kstep, voffB);
        PG8_WAIT_V(6); PG8_BAR;
    }
    for (;;) {
        const bool has_next = S.next(ui + 1, nxt);
        const char* nA = has_next ? (const char*)g.A + (size_t)nxt.pm * tstepA : cA; const char* nB = has_next ? (const char*)g.Bt + (size_t)nxt.pn * tstepB : cB;
        for (int t = 0; t < nt; t += 2) {
            const bool last = (t == nt - 2);
            const char* a1 = cA + (size_t)(t + 1) * kstep;
            const char* a2 = last ? nA : cA + (size_t)(t + 2) * kstep; const char* b2 = last ? nB : cB + (size_t)(t + 2) * kstep;
            const char* a3 = a2 + kstep; const char* b3 = b2 + kstep;
            if (last && has_next) S.a_ready(nxt);
            if constexpr (SP2) {
            PG8_LDB(B0, 0, 0); PG8_LDB(B1, 0, 1); PG8_SCHED; PG8_LDA(At, 0, 0); PG8_STAGE(PG8_SA(1, 1), a1 + hstepA, voffA);
            PG8_WAIT_V(8); PG8_WAIT_L(0); PG8_BAR; PG8_MMA(0, 0, At, B0); PG8_MMA(0, 1, At, B1); PG8_BAR; PG8_SCHED;
            PG8_LDA(At, 0, 1); PG8_STAGE(PG8_SB(0, 0), b2, voffB); PG8_STAGE(PG8_SB(0, 1), b2 + hstepB, voffB); PG8_STAGE(PG8_SA(0, 0), a2, voffA);
            PG8_WAIT_V(8); PG8_WAIT_L(0); PG8_BAR; PG8_MMA(1, 0, At, B0); PG8_MMA(1, 1, At, B1); PG8_BAR; PG8_SCHED;
            PG8_LDB(B0, 1, 0); PG8_LDB(B1, 1, 1); PG8_SCHED; PG8_LDA(At, 1, 0); PG8_STAGE(PG8_SA(0, 1), a2 + hstepA, voffA);
            PG8_WAIT_V(8); PG8_WAIT_L(0); PG8_BAR; PG8_MMA(0, 0, At, B0); PG8_MMA(0, 1, At, B1); PG8_BAR; PG8_SCHED;
            PG8_LDA(At, 1, 1); PG8_STAGE(PG8_SB(1, 0), b3, voffB); PG8_STAGE(PG8_SB(1, 1), b3 + hstepB, voffB); PG8_STAGE(PG8_SA(1, 0), a3, voffA);
            PG8_WAIT_V(8); PG8_WAIT_L(0); PG8_BAR; PG8_MMA(1, 0, At, B0); PG8_MMA(1, 1, At, B1); PG8_BAR; PG8_SCHED;
            } else {
            PG8_LDB(B0, 0, 0); PG8_SCHED; PG8_LDA(At, 0, 0); PG8_STAGE(PG8_SA(1, 1), a1 + hstepA, voffA);
            PG8_WAIT_L(8); PG8_BAR; PG8_WAIT_L(0); PG8_MMA(0, 0, At, B0); PG8_BAR; PG8_SCHED;
            PG8_LDB(B1, 0, 1); PG8_STAGE(PG8_SB(0, 0), b2, voffB);
            PG8_BAR; PG8_WAIT_L(0); PG8_MMA(0, 1, At, B1); PG8_BAR;
            PG8_LDA(At, 0, 1); PG8_STAGE(PG8_SA(0, 0), a2, voffA);
            PG8_BAR; PG8_WAIT_L(0); PG8_MMA(1, 0, At, B0); PG8_BAR; PG8_SCHED;
            PG8_STAGE(PG8_SB(0, 1), b2 + hstepB, voffB);
            PG8_WAIT_V(6); PG8_BAR; PG8_MMA(1, 1, At, B1); PG8_BAR;
            PG8_LDB(B0, 1, 0); PG8_SCHED; PG8_LDA(At, 1, 0); PG8_STAGE(PG8_SA(0, 1), a2 + hstepA, voffA);
            PG8_WAIT_L(8); PG8_BAR; PG8_WAIT_L(0); PG8_MMA(0, 0, At, B0); PG8_BAR; PG8_SCHED;
            PG8_LDB(B1, 1, 1); PG8_STAGE(PG8_SB(1, 0), b3, voffB);
            PG8_BAR; PG8_WAIT_L(0); PG8_MMA(0, 1, At, B1); PG8_BAR;
            PG8_LDA(At, 1, 1); PG8_STAGE(PG8_SA(1, 0), a3, voffA);
            PG8_BAR; PG8_WAIT_L(0); PG8_MMA(1, 0, At, B0); PG8_BAR; PG8_SCHED;
            PG8_STAGE(PG8_SB(1, 1), b3 + hstepB, voffB);
            PG8_WAIT_V(6); PG8_BAR; PG8_MMA(1, 1, At, B1); PG8_BAR;
            }
        }
        if constexpr (ALIGN_EPI) { if (wr == 0) PG8_BAR; }
        if constexpr (!Epi::AFTER_DRAIN) { E(acc, cur, wr, wc, fr, fq); S.done(cur); }
        if (!has_next) break;
#pragma unroll
        for (int a = 0; a < 2; ++a)
#pragma unroll
            for (int b = 0; b < 2; ++b)
#pragma unroll
                for (int m = 0; m < 4; ++m)
#pragma unroll
                    for (int n = 0; n < 2; ++n) acc[a][b][m][n] = (f32x4){0.f, 0.f, 0.f, 0.f};
        cur = nxt; cA = nA; cB = nB; ++ui;
        if constexpr (ALIGN_EPI) { if (wr == 1) PG8_BAR; }
    }
    PG8_WAIT_V(0);
    if constexpr (!ALIGN_EPI) { if (wr == 0) PG8_BAR; }
    PG8_BAR;
    if constexpr (Epi::AFTER_DRAIN) { E.fused(acc, cur, wr, wc, fr, fq, lds, wid, lane); S.done(cur); }
#undef PG8_SA
#undef PG8_SB
#undef PG8_STAGE
#undef PG8_LDA
#undef PG8_LDB
#undef PG8_MMA
#undef PG8_WAIT_V
#undef PG8_WAIT_L
#undef PG8_BAR
#undef PG8_SCHED
}
}

constexpr int DM = 1024, DFF = 2816, MTOK = 98304, MPROMPT = 32768, SEQ_P = 16384, SEQ_S = 4096;
constexpr int NWAVES = 8;
constexpr float LN_EPS = 1e-5f, RMS_EPS = 1e-6f;
constexpr float ALPHA = 1.189207115002721f;
constexpr float QSCALE = 0.10206207261596575f * 1.4426950408889634f;

#define GAS __attribute__((address_space(1)))
#define LAS __attribute__((address_space(3)))
typedef unsigned short bf16;
typedef unsigned v4u __attribute__((ext_vector_type(4)));
typedef unsigned v2u __attribute__((ext_vector_type(2)));
typedef float f32x4 __attribute__((ext_vector_type(4)));
typedef float f32x16 __attribute__((ext_vector_type(16)));
typedef short bf16x8 __attribute__((ext_vector_type(8)));
typedef short s16x4 __attribute__((ext_vector_type(4)));
typedef short v4i16_t __attribute__((ext_vector_type(4)));

constexpr size_t MiB = 1u << 20;
constexpr size_t WS_W1IN = 0, WS_W1OUT = 12 * MiB, WS_W2IN = 18 * MiB, WS_W2OUT = 30 * MiB, WS_WIN = 36 * MiB, WS_WG = 41 * MiB, WS_WUQ = 45 * MiB, WS_WUKV = 46 * MiB,
                 WS_WNAO = 47 * MiB, WS_WMLAO = 48 * MiB, WS_WOUT = 49 * MiB, WS_CTL = 51 * MiB  , WS_ROPE = 52 * MiB  , WS_XB = 54 * MiB, WS_R = 246 * MiB, WS_END = 1023 * MiB;
constexpr size_t R_ACT = 0, R_NAQKV = 0  , R_C = 288 * MiB  , R_Q = 432 * MiB  , R_MLAO = 585 * MiB  , R_NAO = 681 * MiB  ,
                 R_KV = 0  , R_KR = 576 * MiB  , R_G = 0  , R_T = 384 * MiB  ;
static_assert((size_t)DM * 2 * DFF * 2 <= 12 * MiB && (size_t)DFF * DM * 2 <= 6 * MiB && 2304 * 1024 * 2 <= 5 * MiB, "weights map");
static_assert(WS_R + 777 * MiB <= WS_END && WS_XB + (size_t)MTOK * DM * 2 <= WS_R, "ws map");

constexpr int RING_BYTES = 131072, LDS_BYTES = 147456;

__device__ __forceinline__ unsigned f2bf(float f) { unsigned u = __builtin_bit_cast(unsigned, f); return (u + 0x7fffu + ((u >> 16) & 1u)) >> 16; }
__device__ __forceinline__ unsigned pk2(float lo, float hi) { return f2bf(lo) | (f2bf(hi) << 16); }
__device__ __forceinline__ float bflo(unsigned w) { return __uint_as_float(w << 16); }
__device__ __forceinline__ float bfhi(unsigned w) { return __uint_as_float(w & 0xffff0000u); }
__device__ __forceinline__ float wave_sum(float v) {
#pragma unroll
    for (int o = 1; o < 64; o <<= 1) v += __shfl_xor(v, o);
    return v;
}

__device__ __forceinline__ void p0_transpose_item(const float* W, int K, int N, bf16* WT, int dst_row0, LAS float* scr, int kb, int nb, int lane) {
    const int k0 = 64 * kb, n0 = 32 * nb;
#pragma unroll 8
    for (int i = 0; i < 32; ++i) { const int kk = 2 * i + (lane >> 5); scr[kk * 33 + (lane & 31)] = W[(size_t)(k0 + kk) * N + n0 + (lane & 31)]; }
    asm volatile("s_waitcnt lgkmcnt(0)" ::: "memory");
    const int c = lane & 7;
#pragma unroll
    for (int j = 0; j < 4; ++j) { const int n = (lane >> 3) + 8 * j; const LAS float* s = scr + (8 * c) * 33 + n;
        v4u o; o.x = pk2(s[0 * 33], s[1 * 33]); o.y = pk2(s[2 * 33], s[3 * 33]); o.z = pk2(s[4 * 33], s[5 * 33]); o.w = pk2(s[6 * 33], s[7 * 33]);
        *(v4u*)(WT + (size_t)(dst_row0 + n) * K + k0 + 8 * c) = o; }
    asm volatile("s_waitcnt lgkmcnt(0)" ::: "memory");
}

template <bool LN, bool WF32, bool WBF>
__device__ __forceinline__ void rows_phase(const float* X, float* XO, bf16* XB, const float* gam, const float* bet, int row_lo, int row_hi, int gw, int NGW, int lane) {
    constexpr int RB = 4;
    f32x4 g[4], b[4];
    if (LN) {
#pragma unroll
        for (int j = 0; j < 4; ++j) { g[j] = ((const f32x4*)gam)[lane + 64 * j]; b[j] = ((const f32x4*)bet)[lane + 64 * j]; }
    }
    for (int m0 = row_lo + gw * RB; m0 < row_hi; m0 += NGW * RB) {
        f32x4 v[RB][4]; float s[RB];
#pragma unroll
        for (int q = 0; q < RB; ++q) { const f32x4* xr = (const f32x4*)(X + (size_t)(m0 + q - row_lo) * DM) + lane;
#pragma unroll
            for (int j = 0; j < 4; ++j) v[q][j] = xr[64 * j]; }
        if (LN) {
#pragma unroll
            for (int q = 0; q < RB; ++q) { s[q] = 0.f;
#pragma unroll
                for (int j = 0; j < 4; ++j) s[q] += (v[q][j].x + v[q][j].y) + (v[q][j].z + v[q][j].w); }
#pragma unroll
            for (int o = 1; o < 64; o <<= 1)
#pragma unroll
                for (int q = 0; q < RB; ++q) s[q] += __shfl_xor(s[q], o);
            float s2[RB];
#pragma unroll
            for (int q = 0; q < RB; ++q) { const float mean = s[q] * (1.f / DM); s2[q] = 0.f;
#pragma unroll
                for (int j = 0; j < 4; ++j) { v[q][j] = v[q][j] - mean; s2[q] += (v[q][j].x * v[q][j].x + v[q][j].y * v[q][j].y) + (v[q][j].z * v[q][j].z + v[q][j].w * v[q][j].w); } }
#pragma unroll
            for (int o = 1; o < 64; o <<= 1)
#pragma unroll
                for (int q = 0; q < RB; ++q) s2[q] += __shfl_xor(s2[q], o);
#pragma unroll
            for (int q = 0; q < RB; ++q) { const float rstd = 1.f / sqrtf(s2[q] * (1.f / DM) + LN_EPS);
#pragma unroll
                for (int j = 0; j < 4; ++j) v[q][j] = v[q][j] * rstd * g[j] + b[j]; }
        }
#pragma unroll
        for (int q = 0; q < RB; ++q) {
            if (WF32) { f32x4* xo = (f32x4*)(XO + (size_t)(m0 + q) * DM) + lane;
#pragma unroll
                for (int j = 0; j < 4; ++j) xo[64 * j] = v[q][j]; }
            if (WBF) { v2u* o8 = (v2u*)(XB + (size_t)(m0 + q) * DM) + lane;
#pragma unroll
                for (int j = 0; j < 4; ++j) { v2u w; w.x = pk2(v[q][j].x, v[q][j].y); w.y = pk2(v[q][j].z, v[q][j].w); o8[64 * j] = w; } }
        }
    }
}

__device__ __forceinline__ void prep_phase(bf16* C, bf16* KR, const float* qg, const float* kvg, const float* cosT, const float* sinT, int gw, int NGW, int lane) {
    const int li = lane & 15, rq = lane >> 4;
    float gkv[16], gq[24];
#pragma unroll
    for (int k = 0; k < 16; ++k) gkv[k] = kvg[li * 16 + k];
#pragma unroll
    for (int k = 0; k < 24; ++k) gq[k] = qg[li * 24 + k];
    for (int m = gw * 4 + rq; m < MTOK; m += NGW * 4) {
        bf16* row = C + (size_t)m * 768;
        v4u kv[2], qv[3];
#pragma unroll
        for (int k = 0; k < 2; ++k) kv[k] = *(const v4u*)(row + li * 16 + 8 * k);
#pragma unroll
        for (int k = 0; k < 3; ++k) qv[k] = *(const v4u*)(row + 256 + li * 24 + 8 * k);
        const float x1 = __uint_as_float((unsigned)row[640 + li] << 16), x2 = __uint_as_float((unsigned)row[656 + li] << 16);
        float a[16], q[24]; float skv = 0.f, sq = 0.f;
#pragma unroll
        for (int k = 0; k < 2; ++k)
#pragma unroll
            for (int e = 0; e < 4; ++e) { a[8 * k + 2 * e] = bflo(kv[k][e]); a[8 * k + 2 * e + 1] = bfhi(kv[k][e]); }
#pragma unroll
        for (int k = 0; k < 3; ++k)
#pragma unroll
            for (int e = 0; e < 4; ++e) { q[8 * k + 2 * e] = bflo(qv[k][e]); q[8 * k + 2 * e + 1] = bfhi(qv[k][e]); }
#pragma unroll
        for (int k = 0; k < 16; ++k) skv += a[k] * a[k];
#pragma unroll
        for (int k = 0; k < 24; ++k) sq += q[k] * q[k];
#pragma unroll
        for (int o = 1; o < 16; o <<= 1) { skv += __shfl_xor(skv, o); sq += __shfl_xor(sq, o); }
        const float rkv = 1.f / sqrtf(skv * (1.f / 256.f) + RMS_EPS), rq_ = 1.f / sqrtf(sq * (1.f / 384.f) + RMS_EPS);
#pragma unroll
        for (int k = 0; k < 2; ++k) { v4u o;
#pragma unroll
            for (int e = 0; e < 4; ++e) o[e] = pk2(a[8 * k + 2 * e] * rkv * gkv[8 * k + 2 * e], a[8 * k + 2 * e + 1] * rkv * gkv[8 * k + 2 * e + 1]);
            *(v4u*)(row + li * 16 + 8 * k) = o; }
#pragma unroll
        for (int k = 0; k < 3; ++k) { v4u o;
#pragma unroll
            for (int e = 0; e < 4; ++e) o[e] = pk2(q[8 * k + 2 * e] * rq_ * gq[8 * k + 2 * e], q[8 * k + 2 * e + 1] * rq_ * gq[8 * k + 2 * e + 1]);
            *(v4u*)(row + 256 + li * 24 + 8 * k) = o; }
        { const int pos = m < MPROMPT ? (m & (SEQ_P - 1)) : (m & (SEQ_S - 1)); const float c = cosT[pos * 16 + li], sn = sinT[pos * 16 + li];
            KR[(size_t)m * 32 + li] = (bf16)f2bf(x1 * c - x2 * sn); KR[(size_t)m * 32 + 16 + li] = (bf16)f2bf(x1 * sn + x2 * c); }
    }
}

__device__ __forceinline__ void na_task(LAS unsigned char* ldsw, const bf16* QKV, bf16* O, const float* rpb, int seq0, int rows, int r, int j, int h, int lane) {
    const int q = lane & 15, g = lane >> 4;
    int row_start = r - 4; row_start = row_start < 0 ? 0 : (row_start > rows - 8 ? rows - 8 : row_start);
    int slab_start = 16 * j - 8; slab_start = slab_start < 0 ? 0 : (slab_start > 32 ? 32 : slab_start);
    const int qcol = 16 * j + q; int win_start = qcol - 8; win_start = win_start < 0 ? 0 : (win_start > 48 ? 48 : win_start);
    const bf16* qp = QKV + (size_t)(seq0 + r * 64 + qcol) * 1536 + h * 64 + g * 8;
    const bf16x8 qf0 = *(const bf16x8*)qp, qf1 = *(const bf16x8*)(qp + 32);
    f32x4 st[16];
#pragma unroll
    for (int kt = 0; kt < 16; ++kt) {
        const bf16* kp = QKV + (size_t)(seq0 + (row_start + (kt >> 1)) * 64 + slab_start + 16 * (kt & 1) + q) * 1536 + 512 + h * 64 + g * 8;
        const bf16x8 k0 = *(const bf16x8*)kp, k1 = *(const bf16x8*)(kp + 32);
        f32x4 a = (f32x4){0.f, 0.f, 0.f, 0.f};
        a = __builtin_amdgcn_mfma_f32_16x16x32_bf16(k0, qf0, a, 0, 0, 0);
        a = __builtin_amdgcn_mfma_f32_16x16x32_bf16(k1, qf1, a, 0, 0, 0);
        st[kt] = a;
    }
    const float* rp = rpb + h * (15 * 31);
    float mx = -INFINITY;
#pragma unroll
    for (int kt = 0; kt < 16; ++kt) {
        const int dr = row_start + (kt >> 1) - r + 7;
#pragma unroll
        for (int e = 0; e < 4; ++e) {
            const int scol = slab_start + 16 * (kt & 1) + 4 * g + e; int dc = scol - qcol + 15; dc = dc < 0 ? 0 : (dc > 30 ? 30 : dc);
            const bool valid = (scol >= win_start) && (scol < win_start + 16);
            float s = (st[kt][e] * 0.125f + rp[dr * 31 + dc]) * 1.4426950408889634f;
            s = valid ? s : -INFINITY; st[kt][e] = s; mx = fmaxf(mx, s);
        }
    }
    mx = fmaxf(mx, __shfl_xor(mx, 16)); mx = fmaxf(mx, __shfl_xor(mx, 32));
    float sum = 0.f;
#pragma unroll
    for (int kt = 0; kt < 16; ++kt)
#pragma unroll
        for (int e = 0; e < 4; ++e) { const float p = __builtin_amdgcn_exp2f(st[kt][e] - mx); st[kt][e] = p; sum += p; }
    sum += __shfl_xor(sum, 16); sum += __shfl_xor(sum, 32);
    const float inv = 1.0f / sum;
    f32x4 o[4];
#pragma unroll
    for (int c = 0; c < 4; ++c) o[c] = (f32x4){0.f, 0.f, 0.f, 0.f};
    const int q4 = (lane & 15) >> 2, p = lane & 3;
#pragma unroll
    for (int kr = 0; kr < 8; ++kr) {
        v4u vreg[4];
#pragma unroll
        for (int ii = 0; ii < 4; ++ii) { const int rw = 8 * ii + (lane >> 3), ch = lane & 7;
            vreg[ii] = *(const v4u*)(QKV + (size_t)(seq0 + (row_start + kr) * 64 + slab_start + rw) * 1536 + 1024 + h * 64 + ch * 8); }
#pragma unroll
        for (int ii = 0; ii < 4; ++ii) { const int rw = 8 * ii + (lane >> 3), ch = lane & 7; *(LAS v4u*)(ldsw + rw * 144 + ch * 16) = vreg[ii]; }
        asm volatile("s_waitcnt lgkmcnt(0)" ::: "memory");
        v4u pa; pa.x = pg8::cvt_pk_bf16(st[2 * kr][0], st[2 * kr][1]); pa.y = pg8::cvt_pk_bf16(st[2 * kr][2], st[2 * kr][3]);
        pa.z = pg8::cvt_pk_bf16(st[2 * kr + 1][0], st[2 * kr + 1][1]); pa.w = pg8::cvt_pk_bf16(st[2 * kr + 1][2], st[2 * kr + 1][3]);
#pragma unroll
        for (int c = 0; c < 4; ++c) {
            const s16x4 lo = __builtin_bit_cast(s16x4, __builtin_amdgcn_ds_read_tr16_b64_v4i16((LAS v4i16_t*)(ldsw + (4 * g + q4) * 144 + (16 * c + 4 * p) * 2)));
            const s16x4 hi = __builtin_bit_cast(s16x4, __builtin_amdgcn_ds_read_tr16_b64_v4i16((LAS v4i16_t*)(ldsw + (16 + 4 * g + q4) * 144 + (16 * c + 4 * p) * 2)));
            const bf16x8 vb = (bf16x8){lo[0], lo[1], lo[2], lo[3], hi[0], hi[1], hi[2], hi[3]};
            o[c] = __builtin_amdgcn_mfma_f32_16x16x32_bf16(__builtin_bit_cast(bf16x8, pa), vb, o[c], 0, 0, 0);
        }
        asm volatile("s_waitcnt lgkmcnt(0)" ::: "memory");
    }
#pragma unroll
    for (int e = 0; e < 4; ++e) { const float li = __shfl(inv, 4 * g + e);
        bf16* op = O + (size_t)(seq0 + r * 64 + 16 * j + 4 * g + e) * 512 + h * 64 + (lane & 15);
#pragma unroll
        for (int c = 0; c < 4; ++c) op[16 * c] = (bf16)f2bf(o[c][e] * li); }
}

namespace mla {
constexpr int SLOT = 20480;
constexpr int WSF = 5 * SLOT;
#define MX3(a, b, c) __builtin_fmaxf(__builtin_fmaxf((a), (b)), (c))
#define SBAR() __builtin_amdgcn_sched_barrier(0)
__device__ __forceinline__ int crow(int r, int hi) { return (r & 3) + 8 * (r >> 2) + 4 * hi; }
__device__ __forceinline__ unsigned cvtpk(float lo, float hi) { return pg8::cvt_pk_bf16(lo, hi); }
__device__ __forceinline__ void glds16(const void* gsrc, unsigned lds_dst) { unsigned keep;
    asm volatile("s_mov_b32 %0, m0\n\ts_mov_b32 m0, %2\n\ts_nop 0\n\tglobal_load_lds_dwordx4 %1, off\n\ts_mov_b32 m0, %0" : "=&s"(keep) : "v"(gsrc), "s"(lds_dst) : "memory"); }
#define WAIT_BAR(N) asm volatile("s_waitcnt vmcnt(" #N ") lgkmcnt(0)\n\ts_barrier" ::: "memory")
constexpr int NSLOT = 5, PF = 4;
template <int THR>
__device__ __forceinline__ void unit(LAS unsigned char* lds, const bf16* Q, const bf16* KV, const bf16* KR, bf16* O, int tok0, int nkt, int h, int qb) {
    int tid_raw = threadIdx.x; asm volatile("" : "+v"(tid_raw));
    const int tid = tid_raw, lane = tid & 63, r32 = lane & 31, hi = lane >> 5; const int wid = __builtin_amdgcn_readfirstlane(tid >> 6);
    LAS float* wsf = (LAS float*)(lds + WSF) + wid * 64;
    const unsigned lds0 = (unsigned)(uintptr_t)lds;
    const bf16* ksrc = KV + (size_t)(tok0 + lane) * 1024 + h * 64 + wid * 8;
    const bf16* vsrc = KV + (size_t)(tok0 + 16 * (wid & 3) + (lane >> 2)) * 1024 + 512 + h * 64 + (wid >> 2) * 32 + (lane & 3) * 8;
    const bf16* rsrc = KR + (size_t)(tok0 + lane) * 32 + (wid & 3) * 8;
    const unsigned kdst = lds0 + wid * 1024, vdst = lds0 + 12288 + wid * 1024, rdst = lds0 + 8192 + (wid & 3) * 1024;
    const bool do_r = wid < 4;
#define DMA_TILE(tt, slot) do { const int t_ = (tt) < nkt ? (tt) : nkt - 1; \
        glds16(ksrc + (size_t)t_ * 65536, (unsigned)__builtin_amdgcn_readfirstlane(kdst + (slot))); \
        glds16(vsrc + (size_t)t_ * 65536, (unsigned)__builtin_amdgcn_readfirstlane(vdst + (slot))); \
        if (do_r) glds16(rsrc + (size_t)t_ * 2048, (unsigned)__builtin_amdgcn_readfirstlane(rdst + (slot))); } while (0)
    const bf16* Qw = Q + (size_t)(tok0 + qb * 256 + wid * 32 + r32) * 768;
    bf16x8 qr[6];
#pragma unroll
    for (int d0 = 0; d0 < 4; ++d0) qr[d0] = *(const bf16x8*)(Qw + h * 64 + d0 * 16 + hi * 8);
    qr[4] = *(const bf16x8*)(Qw + 512 + h * 32 + hi * 8); qr[5] = *(const bf16x8*)(Qw + 512 + h * 32 + 16 + hi * 8);
    DMA_TILE(0, 0); DMA_TILE(1, SLOT); DMA_TILE(2, 2 * SLOT); DMA_TILE(3, 3 * SLOT);
    const int koff = hi * 1024 + r32 * 16;
    const int voff = 12288 + ((lane >> 4) & 1) * 32 + (lane & 3) * 8 + (4 * hi + ((lane & 15) >> 2)) * 64;
    f32x16 o0, o1, negm, pS0, pS1;
#pragma unroll
    for (int r = 0; r < 16; ++r) { o0[r] = 0.f; o1[r] = 0.f; pS0[r] = 0.f; pS1[r] = 0.f; }
    float mhat = 0.f, l = 0.f;
    if (do_r) { WAIT_BAR(6); } else { WAIT_BAR(4); }
#pragma unroll
    for (int d0 = 0; d0 < 6; ++d0) {
        const bf16x8 b0 = *(const LAS bf16x8*)(lds + koff + d0 * 2048), b1 = *(const LAS bf16x8*)(lds + koff + d0 * 2048 + 512);
        pS0 = __builtin_amdgcn_mfma_f32_32x32x16_bf16(b0, qr[d0], pS0, 0, 0, 0);
        pS1 = __builtin_amdgcn_mfma_f32_32x32x16_bf16(b1, qr[d0], pS1, 0, 0, 0);
    }
    {
        float rm = MX3(pS0[0], pS0[1], pS1[0]);
#pragma unroll
        for (int r = 1; r < 16; r += 1) rm = MX3(rm, pS0[r], pS1[r]);
        auto rr = __builtin_amdgcn_permlane32_swap(__float_as_uint(rm), __float_as_uint(rm), false, false); rm = __builtin_fmaxf(__uint_as_float(rr[0]), __uint_as_float(rr[1]));
        mhat = rm;
#pragma unroll
        for (int r = 0; r < 16; ++r) { pS0[r] -= rm; pS1[r] -= rm; negm[r] = -mhat; }
    }
    int s_prev = 4 * SLOT, s_cur = 0, s_n1 = SLOT;
    for (int t = 0; t < nkt; ++t) {
        const bool more1 = (t + 1 < nkt);
        DMA_TILE(t + PF, s_prev);
        bf16x8 kfa[6], kfb[6];
#pragma unroll
        for (int d0 = 0; d0 < 6; ++d0) { kfa[d0] = *(const LAS bf16x8*)(lds + s_n1 + koff + d0 * 2048); kfb[d0] = *(const LAS bf16x8*)(lds + s_n1 + koff + d0 * 2048 + 512); }
        f32x16 pN0 = negm, pN1 = negm;
        unsigned wA[8], wB[8]; float sacc = 0.f;
        SBAR();
#pragma unroll
        for (int i = 0; i < 12; ++i) {
            const int d0 = i >> 1;
            if (i & 1) pN1 = __builtin_amdgcn_mfma_f32_32x32x16_bf16(kfb[d0], qr[d0], pN1, 0, 0, 0);
            else       pN0 = __builtin_amdgcn_mfma_f32_32x32x16_bf16(kfa[d0], qr[d0], pN0, 0, 0, 0);
            SBAR();
#pragma unroll
            for (int r = (i * 16) / 12; r < ((i + 1) * 16) / 12; ++r) {
                pS0[r] = __builtin_amdgcn_exp2f(pS0[r]); pS1[r] = __builtin_amdgcn_exp2f(pS1[r]);
                sacc += pS0[r]; sacc += pS1[r];
                if (r & 1) { wA[r >> 1] = cvtpk(pS0[r - 1], pS0[r]); wB[r >> 1] = cvtpk(pS1[r - 1], pS1[r]); }
            }
            SBAR();
        }
        l += sacc;
        const bf16x8 pw0 = __builtin_bit_cast(bf16x8, (v4u){wA[0], wA[1], wA[2], wA[3]}), pw1 = __builtin_bit_cast(bf16x8, (v4u){wA[4], wA[5], wA[6], wA[7]}),
                     pw2 = __builtin_bit_cast(bf16x8, (v4u){wB[0], wB[1], wB[2], wB[3]}), pw3 = __builtin_bit_cast(bf16x8, (v4u){wB[4], wB[5], wB[6], wB[7]});
#define VFRAG(dst, off_) do { const s16x4 lo_ = __builtin_bit_cast(s16x4, __builtin_amdgcn_ds_read_tr16_b64_v4i16((LAS v4i16_t*)(lds + s_cur + voff + (off_)))); \
        const s16x4 hi_ = __builtin_bit_cast(s16x4, __builtin_amdgcn_ds_read_tr16_b64_v4i16((LAS v4i16_t*)(lds + s_cur + voff + (off_) + 512))); \
        dst = (bf16x8){lo_[0], lo_[1], lo_[2], lo_[3], hi_[0], hi_[1], hi_[2], hi_[3]}; } while (0)
        bf16x8 va0, vb0, va1, vb1, va2, vb2, va3, vb3;
        VFRAG(va0, 0); VFRAG(vb0, 4096); VFRAG(va1, 1024); VFRAG(vb1, 4096 + 1024);
        o0 = __builtin_amdgcn_mfma_f32_32x32x16_bf16(pw0, va0, o0, 0, 0, 0);
        VFRAG(va2, 2048); VFRAG(vb2, 4096 + 2048);
        o1 = __builtin_amdgcn_mfma_f32_32x32x16_bf16(pw0, vb0, o1, 0, 0, 0);
        VFRAG(va3, 3072); VFRAG(vb3, 4096 + 3072);
        o0 = __builtin_amdgcn_mfma_f32_32x32x16_bf16(pw1, va1, o0, 0, 0, 0);
        o1 = __builtin_amdgcn_mfma_f32_32x32x16_bf16(pw1, vb1, o1, 0, 0, 0);
        SBAR();
        float rm = MX3(pN0[0], pN0[1], pN1[0]);
        o0 = __builtin_amdgcn_mfma_f32_32x32x16_bf16(pw2, va2, o0, 0, 0, 0);
        SBAR();
#pragma unroll
        for (int r = 1; r < 6; ++r) rm = MX3(rm, pN0[r], pN1[r]);
        o1 = __builtin_amdgcn_mfma_f32_32x32x16_bf16(pw2, vb2, o1, 0, 0, 0);
        SBAR();
#pragma unroll
        for (int r = 6; r < 11; ++r) rm = MX3(rm, pN0[r], pN1[r]);
        o0 = __builtin_amdgcn_mfma_f32_32x32x16_bf16(pw3, va3, o0, 0, 0, 0);
        SBAR();
#pragma unroll
        for (int r = 11; r < 16; ++r) rm = MX3(rm, pN0[r], pN1[r]);
        o1 = __builtin_amdgcn_mfma_f32_32x32x16_bf16(pw3, vb3, o1, 0, 0, 0);
        SBAR();
#undef VFRAG
        { auto rr = __builtin_amdgcn_permlane32_swap(__float_as_uint(rm), __float_as_uint(rm), false, false); rm = __builtin_fmaxf(__uint_as_float(rr[0]), __uint_as_float(rr[1])); }
        if (more1 && __any(rm > (float)THR)) {
            const float dl = __builtin_fmaxf(rm, 0.f); mhat += dl;
#pragma unroll
            for (int r = 0; r < 16; ++r) { pN0[r] -= dl; pN1[r] -= dl; negm[r] = -mhat; }
            const float f = __builtin_amdgcn_exp2f(-dl); l *= f;
            if (hi == 0) wsf[r32] = f;
            asm volatile("s_waitcnt lgkmcnt(0)" ::: "memory");
#pragma unroll
            for (int r = 0; r < 16; ++r) { const float fr = wsf[crow(r, hi)]; o0[r] *= fr; o1[r] *= fr; }
            asm volatile("s_waitcnt lgkmcnt(0)" ::: "memory");
        }
        if (do_r) { WAIT_BAR(6); } else { WAIT_BAR(4); }
        pS0 = pN0; pS1 = pN1;
        s_prev = s_cur; s_cur = s_n1; s_n1 = (s_n1 == (NSLOT - 1) * SLOT) ? 0 : s_n1 + SLOT;
    }
    { auto rr = __builtin_amdgcn_permlane32_swap(__float_as_uint(l), __float_as_uint(l), false, false); l = __uint_as_float(rr[0]) + __uint_as_float(rr[1]); }
    if (hi == 0) wsf[32 + r32] = l;
    asm volatile("s_waitcnt lgkmcnt(0)" ::: "memory");
    bf16* Ow = O + (size_t)(tok0 + qb * 256 + wid * 32) * 512 + h * 64 + r32;
#pragma unroll
    for (int r = 0; r < 16; ++r) { const int row = crow(r, hi); const float li = 1.0f / wsf[32 + row];
        Ow[(size_t)row * 512] = (bf16)f2bf(o0[r] * li); Ow[(size_t)row * 512 + 32] = (bf16)f2bf(o1[r] * li); }
    WAIT_BAR(0);
#undef DMA_TILE
}
__device__ __forceinline__ void decode(int idx, int& tok0, int& nkt, int& h, int& qb) {
    if (idx < 1024) { const int pair = idx >> 6; qb = idx & 63; h = pair & 7; tok0 = (pair >> 3) * SEQ_P; nkt = SEQ_P / 64; }
    else { const int i2 = idx - 1024, pair = i2 >> 4; qb = i2 & 15; h = pair & 7; tok0 = MPROMPT + (pair >> 3) * SEQ_S; nkt = SEQ_S / 64; }
}
}

#define XB_TMO      128
#define XB_XCNT(j)  (256  + 64 * (j))
#define XB_XSUB(j)  (1280 + 64 * (j))
#define XB_XGEN(j)  (2304 + 64 * (j))
#define XB_TOP      3328
#define XB_TOPGEN   3392
#define XCD_BAR_WORDS 3456
#define XB_SPIN_CAP (1u << 18)

__device__ __forceinline__ unsigned xb_ld(unsigned* p)              { return __hip_atomic_load(p, __ATOMIC_RELAXED, __HIP_MEMORY_SCOPE_AGENT); }
__device__ __forceinline__ unsigned xb_add(unsigned* p, unsigned v) { return __hip_atomic_fetch_add(p, v, __ATOMIC_RELAXED, __HIP_MEMORY_SCOPE_AGENT); }
__device__ __forceinline__ unsigned xb_xcc_id() { return (unsigned)__builtin_amdgcn_s_getreg((3 << 11) | 20) & 0xFu; }
#define XB_SPIN(cond, bar) do { unsigned _sp = 0; while (cond) { __builtin_amdgcn_s_sleep(1); \
    if ((++_sp & 255u) == 0u) { if (xb_ld(&(bar)[XB_TMO])) break; if (_sp > XB_SPIN_CAP) { atomicAdd(&(bar)[XB_TMO], 1u); break; } } } } while (0)

struct XcdBarrier {
    unsigned* bar; unsigned x;
    volatile LAS unsigned* st;
};

__device__ __forceinline__ XcdBarrier xcd_barrier_post(unsigned* bar, volatile LAS unsigned* st) {
    XcdBarrier b; b.bar = bar; b.x = xb_xcc_id(); b.st = st;
    if (threadIdx.x == 0) (void)xb_add(&bar[XB_XCNT(b.x)], 1u);
    return b;
}
__device__ __forceinline__ void xcd_barrier_complete(unsigned* bar, unsigned x, unsigned& nloc, unsigned& nx) {
    const unsigned G = gridDim.x * gridDim.y * gridDim.z;
    unsigned sum, cnt, mine, sp = 0u;
    for (;;) {
        sum = 0u; cnt = 0u; mine = 0u;
#pragma unroll
        for (unsigned j = 0; j < 16; ++j) { const unsigned c = xb_ld(&bar[XB_XCNT(j)]); sum += c; cnt += (c > 0u) ? 1u : 0u; mine = (j == x) ? c : mine; }
        if (sum == G) break;
        __builtin_amdgcn_s_sleep(1);
        if ((++sp & 255u) == 0u) { if (xb_ld(&bar[XB_TMO])) break; if (sp > XB_SPIN_CAP) { atomicAdd(&bar[XB_TMO], 1u); break; } }
    }
    nloc = mine > 0u ? mine : 1u; nx = cnt > 0u ? cnt : 1u;
}

__device__ __forceinline__ void xcd_barrier(const XcdBarrier& b) {
    asm volatile("s_waitcnt vmcnt(0)" ::: "memory");
    __syncthreads();
    if (threadIdx.x == 0) {
        unsigned* bar = b.bar;
        __builtin_amdgcn_s_waitcnt(0);
        unsigned nloc = b.st[0], nx = b.st[1];
        if (nloc == 0u) { xcd_barrier_complete(bar, b.x, nloc, nx); b.st[0] = nloc; b.st[1] = nx; }
        const unsigned old = xb_add(&bar[XB_XSUB(b.x)], 1u);
        const unsigned gen = old / nloc;
        if (old + 1u == (gen + 1u) * nloc) {
            __builtin_amdgcn_fence(__ATOMIC_RELEASE, "agent");
            asm volatile("s_waitcnt vmcnt(0)" ::: "memory");
            const unsigned og = xb_add(&bar[XB_TOP], 1u);
            const unsigned tg = og / nx;
            if (og + 1u == (tg + 1u) * nx) xb_add(&bar[XB_TOPGEN], 1u);
            else XB_SPIN(xb_ld(&bar[XB_TOPGEN]) == tg, bar);
            __builtin_amdgcn_fence(__ATOMIC_ACQUIRE, "agent");
            xb_add(&bar[XB_XGEN(b.x)], 1u);
            asm volatile("s_waitcnt vmcnt(0)" ::: "memory");
        } else {
            XB_SPIN(xb_ld(&bar[XB_XGEN(b.x)]) == gen, bar);
            __builtin_amdgcn_fence(__ATOMIC_ACQUIRE, "agent");
            asm volatile("s_waitcnt vmcnt(0)" ::: "memory");
        }
    }
    __syncthreads();
}

#ifndef SKIP_MLA
#define MLA_UNIT_CALL mla::unit<8>(lds, QB, KVB, KRB, MLAO, tok0, nkt, h, qb)
#else
#define MLA_UNIT_CALL (void)0
#endif
struct Args { const float* in[22]; float* out; unsigned char* ws; float inv_freq[16]; };
enum { I_XP = 0, I_XS, I_F1IN, I_F1OUT, I_LN1G, I_LN1B, I_WIN, I_BGATE, I_RPB, I_QNG, I_KVNG, I_WUQ, I_WUKV, I_WNAO, I_WMLAO, I_WOUT, I_LN2G, I_LN2B, I_F2IN, I_F2OUT, I_LN3G, I_LN3B };

#ifndef NA_SCALE
#define NA_SCALE 1.0f
#endif
#ifndef PH_LAST
#define PH_LAST 99
#endif

__global__ void __launch_bounds__(NWAVES * 64, 2) fwd_megakernel(Args a) {
    extern __shared__ __attribute__((aligned(16))) unsigned char lds_raw[];
    LAS unsigned char* lds = (LAS unsigned char*)lds_raw;
    cg::grid_group grid = cg::this_grid();
    const int G = gridDim.x, bx = blockIdx.x, NGW = G * NWAVES;
#define FRESH_IDS() int tid = threadIdx.x; asm volatile("" : "+v"(tid)); const int lane = tid & 63, wave = __builtin_amdgcn_readfirstlane(tid >> 6), gw = bx * NWAVES + wave; (void)lane; (void)gw
    unsigned char* ws = a.ws;
    bf16 *W1in = (bf16*)(ws + WS_W1IN), *W1out = (bf16*)(ws + WS_W1OUT), *W2in = (bf16*)(ws + WS_W2IN), *W2out = (bf16*)(ws + WS_W2OUT), *Win = (bf16*)(ws + WS_WIN), *Wg = (bf16*)(ws + WS_WG),
         *Wuq = (bf16*)(ws + WS_WUQ), *Wukv = (bf16*)(ws + WS_WUKV), *Wnao = (bf16*)(ws + WS_WNAO), *Wmlao = (bf16*)(ws + WS_WMLAO), *Wout = (bf16*)(ws + WS_WOUT);
    float* cosT = (float*)(ws + WS_ROPE); float* sinT = cosT + 16384 * 16;
    bf16* XB = (bf16*)(ws + WS_XB);
    unsigned char* R = ws + WS_R;
    bf16 *ACT = (bf16*)(R + R_ACT), *NAQKV = (bf16*)(R + R_NAQKV), *CB = (bf16*)(R + R_C), *QB = (bf16*)(R + R_Q), *MLAO = (bf16*)(R + R_MLAO), *NAO = (bf16*)(R + R_NAO),
         *KVB = (bf16*)(R + R_KV), *KRB = (bf16*)(R + R_KR), *GB = (bf16*)(R + R_G), *TB = (bf16*)(R + R_T);
    float* out = a.out;
    volatile LAS unsigned* MISC = (volatile LAS unsigned*)(lds + RING_BYTES + 320);
    if (threadIdx.x < 32) MISC[threadIdx.x] = 0u;
    __syncthreads();
    XcdBarrier xbar = xcd_barrier_post((unsigned*)(ws + WS_CTL), MISC + 8);
#define GRID_SYNC_CG() do { asm volatile("s_waitcnt vmcnt(0) lgkmcnt(0)" ::: "memory"); grid.sync(); asm volatile("" ::: "memory"); } while (0)
#define GRID_SYNC() do { asm volatile("" ::: "memory"); xcd_barrier(xbar); asm volatile("" ::: "memory"); } while (0)

#ifndef REP_P0
#define REP_P0 1
#endif
    for (int rep0_ = 0; rep0_ < REP_P0; ++rep0_) {
        FRESH_IDS();
        LAS float* scr = (LAS float*)(lds + wave * 16384);
        constexpr int I_FIN = 16 * 176, I_FOUT = 44 * 32, I_MIN = 16 * 133, I_UQ = 6 * 24, I_UKV = 4 * 32, I_O512 = 8 * 32, I_O1024 = 16 * 32;
        constexpr int NITEMS = 2 * I_FIN + 2 * I_FOUT + I_MIN + I_UQ + I_UKV + 2 * I_O512 + I_O1024;
        for (int it = gw; it < NITEMS; it += NGW) {
            int r = it;
            if (r < 2 * I_FIN) { const int which = r / I_FIN; r -= which * I_FIN; const int kb = r / 176, nb = r % 176; const int c0 = 32 * nb, s = c0 / DFF, j0 = c0 % DFF;
                p0_transpose_item(a.in[which ? I_F2IN : I_F1IN], DM, 2 * DFF, which ? W2in : W1in, 256 * (j0 / 128) + 128 * s + (j0 % 128), scr, kb, nb, lane); continue; }
            r -= 2 * I_FIN;
            if (r < 2 * I_FOUT) { const int which = r / I_FOUT; r -= which * I_FOUT; const int kb = r / 32, nb = r % 32;
                p0_transpose_item(a.in[which ? I_F2OUT : I_F1OUT], DFF, DM, which ? W2out : W1out, 32 * nb, scr, kb, nb, lane); continue; }
            r -= 2 * I_FOUT;
            if (r < I_MIN) { const int kb = r / 133, nb = r % 133; const int c0 = 32 * nb; bf16* dst = Win; int drow;
                if (c0 < 1536) drow = c0; else if (c0 < 1920) drow = 1536 + 256 + (c0 - 1536); else if (c0 < 2176) drow = 1536 + (c0 - 1920); else if (c0 < 2208) drow = 1536 + 640; else { dst = Wg; drow = c0 - 2208; }
                p0_transpose_item(a.in[I_WIN], DM, 4256, dst, drow, scr, kb, nb, lane); continue; }
            r -= I_MIN;
            if (r < I_UQ) { const int kb = r / 24, nb = r % 24; const int hh = nb / 3, part = nb % 3; const int drow = part < 2 ? hh * 64 + 32 * part : 512 + hh * 32;
                p0_transpose_item(a.in[I_WUQ], 384, 768, Wuq, drow, scr, kb, nb, lane); continue; }
            r -= I_UQ;
            if (r < I_UKV) { const int kb = r / 32, nb = r % 32; const int hh = nb / 4, part = nb % 4; const int drow = part < 2 ? hh * 64 + 32 * part : 512 + hh * 64 + 32 * (part - 2);
                p0_transpose_item(a.in[I_WUKV], 256, 1024, Wukv, drow, scr, kb, nb, lane); continue; }
            r -= I_UKV;
            if (r < 2 * I_O512) { const int which = r / I_O512; r -= which * I_O512; const int kb = r / 32, nb = r % 32;
                p0_transpose_item(a.in[which ? I_WMLAO : I_WNAO], 512, DM, which ? Wmlao : Wnao, 32 * nb, scr, kb, nb, lane); continue; }
            r -= 2 * I_O512;
            { const int kb = r / 32, nb = r % 32; p0_transpose_item(a.in[I_WOUT], DM, DM, Wout, 32 * nb, scr, kb, nb, lane); }
        }
        const int gt = bx * (NWAVES * 64) + tid, NGT = G * NWAVES * 64;
        for (int i = gt; i < 96 * 1024 * 2 / 16; i += NGT) ((v4u*)(Win + (size_t)2208 * 1024))[i] = (v4u){0u, 0u, 0u, 0u};
        for (int i = gt; i < 16384 * 16; i += NGT) { const int pos = i >> 4, k = i & 15; const float ang = (float)pos * a.inv_freq[k];
            const double rev = (double)ang * 0.15915494309189535; const float fr = (float)(rev - floor(rev));
            cosT[i] = __builtin_amdgcn_cosf(fr); sinT[i] = __builtin_amdgcn_sinf(fr); }
        rows_phase<false, false, true>(a.in[I_XP], nullptr, XB, nullptr, nullptr, 0, MPROMPT, gw, NGW, lane);
        rows_phase<false, false, true>(a.in[I_XS], nullptr, XB, nullptr, nullptr, MPROMPT, MTOK, gw, NGW, lane);
    }
    GRID_SYNC_CG();
#define FFN_BLOCK(WIN_, WOUT_, BASE0_, BASE1_, SPLIT_, LNG_, LNB_, WBF_) do { \
        { pg8::Gemm g{XB, WIN_, MTOK, 2 * DFF, DM, DM}; pg8::StaticOrder S; S.init(MTOK, 2 * DFF, G, bx); pg8::EpiSwiGLU E{ACT, DFF}; \
          pg8::gemm_phase<pg8::EpiSwiGLU, pg8::StaticOrder, true, true>(lds, g, S, E); } \
        GRID_SYNC(); \
        { pg8::Gemm g{ACT, WOUT_, MTOK, DM, DFF, DFF}; pg8::StaticOrder S; S.init(MTOK, DM, G, bx); pg8::EpiResid E{BASE0_, BASE1_, SPLIT_, out, ALPHA, 0.5f}; \
          pg8::gemm_phase<pg8::EpiResid, pg8::StaticOrder, true, true>(lds, g, S, E); } \
        GRID_SYNC(); \
        { FRESH_IDS(); rows_phase<true, true, WBF_>(out, out, XB, LNG_, LNB_, 0, MTOK, gw, NGW, lane); } \
    } while (0)

#ifdef REP_SYNC
    for (int i_ = 0; i_ < REP_SYNC; ++i_) { GRID_SYNC(); }
#endif
#ifdef REP_P1
    { pg8::Gemm g{XB, W1in, MTOK, 2 * DFF, DM, DM}; pg8::StaticOrder S; S.init(MTOK, 2 * DFF, G, bx); pg8::EpiSwiGLU E{ACT, DFF};
      pg8::gemm_phase<pg8::EpiSwiGLU, pg8::StaticOrder, true, true>(lds, g, S, E); }
    GRID_SYNC();
#endif
    FFN_BLOCK(W1in, W1out, a.in[I_XP], a.in[I_XS] - (size_t)MPROMPT * DM, MPROMPT / 256, a.in[I_LN1G], a.in[I_LN1B], true);
    GRID_SYNC();
    { pg8::Gemm g{XB, Win, MTOK, 2304, DM, DM}; pg8::StaticOrder S; S.init(MTOK, 2304, G, bx); pg8::EpiBf16<0> E{NAQKV, 1536, 6, CB, 768, nullptr};
      pg8::gemm_phase<pg8::EpiBf16<0>, pg8::StaticOrder, true, true>(lds, g, S, E); }
    GRID_SYNC();
    { FRESH_IDS(); prep_phase(CB, KRB + 0, a.in[I_QNG], a.in[I_KVNG], cosT, sinT, gw, NGW, lane); }
#ifndef REP_NA
#define REP_NA 1
#endif
    for (int rep_ = 0; rep_ < REP_NA; ++rep_) { FRESH_IDS();
    for (int ub = bx; ub < MTOK / 16; ub += G) {
        const int tok = 16 * ub; int seq0, rows;
        if (tok < MPROMPT) { seq0 = (tok / SEQ_P) * SEQ_P; rows = SEQ_P / 64; } else { seq0 = MPROMPT + ((tok - MPROMPT) / SEQ_S) * SEQ_S; rows = SEQ_S / 64; }
        const int pos = tok - seq0;
#ifndef SKIP_NA
        na_task(lds + wave * 4608, NAQKV, NAO, a.in[I_RPB], seq0, rows, pos >> 6, (pos & 63) >> 4, wave, lane);
#endif
    } }
    GRID_SYNC();
    { pg8::Gemm g{CB + 256, Wuq, MTOK, 768, 384, 768}; pg8::StaticOrder S; S.init(MTOK, 768, G, bx); pg8::EpiQRope E{QB, cosT, sinT, QSCALE};
      pg8::gemm_phase<pg8::EpiQRope, pg8::StaticOrder, true, true>(lds, g, S, E); }
    { pg8::Gemm g{CB, Wukv, MTOK, 1024, 256, 768}; pg8::StaticOrder S; S.init(MTOK, 1024, G, bx); pg8::EpiBf16<0> E{KVB, 1024, 99, nullptr, 0, nullptr};
      pg8::gemm_phase<pg8::EpiBf16<0>, pg8::StaticOrder, true, true>(lds, g, S, E); }
    GRID_SYNC();
#ifndef REP_MLA
#define REP_MLA 1
#endif
    for (int rep_ = 0; rep_ < REP_MLA; ++rep_) {
        if (G == 256) {
            const int xcd = bx & 7, l = bx >> 3;
            for (int i = 0; i < 12; ++i) {
                int idx;
                if (i < 4) { const int pair = xcd + 8 * (i >> 1), qb = 2 * l + (i & 1); idx = pair * 64 + qb; }
                else { const int u = (i - 4) * 32 + l; const int pair = xcd + 8 * (u >> 4); idx = 1024 + pair * 16 + (u & 15); }
                int tok0, nkt, h, qb; mla::decode(idx, tok0, nkt, h, qb);
                MLA_UNIT_CALL;
            }
        } else {
            for (int idx = bx; idx < 3072; idx += G) { int tok0, nkt, h, qb; mla::decode(idx, tok0, nkt, h, qb); MLA_UNIT_CALL; }
        }
    }
    GRID_SYNC();
#ifdef REP_P8
    { pg8::Gemm g{XB, Wg, MTOK, 2048, DM, DM}; pg8::StaticOrder S; S.init(MTOK, 2048, G, bx); pg8::EpiBf16<1> E{GB, 2048, 99, nullptr, 0, a.in[I_BGATE]};
      pg8::gemm_phase<pg8::EpiBf16<1>, pg8::StaticOrder, true, true>(lds, g, S, E); }
    GRID_SYNC();
#endif
    { pg8::Gemm g{XB, Wg, MTOK, 2048, DM, DM}; pg8::StaticOrder S; S.init(MTOK, 2048, G, bx); pg8::EpiBf16<1> E{GB, 2048, 99, nullptr, 0, a.in[I_BGATE]};
      pg8::gemm_phase<pg8::EpiBf16<1>, pg8::StaticOrder, true, true>(lds, g, S, E); }
    GRID_SYNC();
    { pg8::Gemm g{NAO, Wnao, MTOK, DM, 512, 512}; pg8::StaticOrder S; S.init(MTOK, DM, G, bx); pg8::EpiGateMul<0> E{GB, 2048, TB, NA_SCALE};
      pg8::gemm_phase<pg8::EpiGateMul<0>, pg8::StaticOrder, true, true>(lds, g, S, E); }
    __syncthreads();
#ifndef NO_MLA_BRANCH
    { pg8::Gemm g{MLAO, Wmlao, MTOK, DM, 512, 512}; pg8::StaticOrder S; S.init(MTOK, DM, G, bx); pg8::EpiGateMul<1> E{GB + 1024, 2048, TB, 1.0f};
      pg8::gemm_phase<pg8::EpiGateMul<1>, pg8::StaticOrder, true, true>(lds, g, S, E); }
#endif
    GRID_SYNC();
    { pg8::Gemm g{TB, Wout, MTOK, DM, DM, DM}; pg8::StaticOrder S; S.init(MTOK, DM, G, bx); pg8::EpiResid E{out, out, 0, out, ALPHA, 1.0f};
      pg8::gemm_phase<pg8::EpiResid, pg8::StaticOrder, true, true>(lds, g, S, E); }
    GRID_SYNC();
    { FRESH_IDS(); rows_phase<true, true, true>(out, out, XB, a.in[I_LN2G], a.in[I_LN2B], 0, MTOK, gw, NGW, lane); }
    GRID_SYNC();
    FFN_BLOCK(W2in, W2out, out, out, 0, a.in[I_LN3G], a.in[I_LN3B], false);
}

extern "C" void kernel_launch(void* const* d_in, const int* in_sizes, int n_in, void* d_out, int out_size, void* d_ws, size_t ws_size, hipStream_t stream) {
    static int grid = 0;
    if (grid == 0) {
        if (n_in != 22 || out_size != MTOK * DM || ws_size < WS_END) { fprintf(stderr, "kernel_launch: unexpected shapes (n_in %d, out %d, ws %zu)\n", n_in, out_size, ws_size); grid = -1; return; }
        int dev = 0, cus = 0, per_cu = 0;
        hipGetDevice(&dev); hipDeviceGetAttribute(&cus, hipDeviceAttributeMultiprocessorCount, dev);
        hipFuncSetAttribute((const void*)fwd_megakernel, hipFuncAttributeMaxDynamicSharedMemorySize, LDS_BYTES);
        hipOccupancyMaxActiveBlocksPerMultiprocessor(&per_cu, (const void*)fwd_megakernel, NWAVES * 64, LDS_BYTES);
        if (per_cu < 1) per_cu = 1;
        (void)hipGetLastError();
        grid = cus * per_cu;
    }
    if (grid < 0) return;
    if (hipMemsetAsync((char*)d_ws + WS_CTL, 0, 16384, stream) != hipSuccess) { fprintf(stderr, "kernel_launch: memset of the barrier words failed\n"); return; }
    Args a{};
    for (int i = 0; i < 22; ++i) a.in[i] = (const float*)d_in[i];
    a.out = (float*)d_out; a.ws = (unsigned char*)d_ws;
    for (int i = 0; i < 16; ++i) a.inv_freq[i] = 1.0f / powf(10000.0f, (float)(2 * i) / 32.0f);
    void* args[] = {&a};
    hipError_t e = hipLaunchCooperativeKernel((const void*)fwd_megakernel, dim3(grid), dim3(NWAVES * 64), args, LDS_BYTES, stream);
    if (e != hipSuccess) fprintf(stderr, "cooperative launch failed: %s (grid %d)\n", hipGetErrorString(e), grid);
}
```
